# Optimizing an MI355X kernel written in HIP

```python
import math
import jax, jax.numpy as jnp
from jax import lax
import numpy as np

D_MODEL = 1024
BATCH = 2
SEQ = 8192
DEPTH = 1

D_POOL = D_MODEL
POOL_WINDOWS = (2, 4, 8, 16)
POOL_GROUPS = len(POOL_WINDOWS)
POOL_GROUP_WIDTH = D_POOL // POOL_GROUPS
D_SSM = D_MODEL
SSM_GROUP = 16
SSM_GROUPS = D_SSM // SSM_GROUP
SSM_STATE = 64
DT_MIN = 1e-3
DT_MAX = 1e-1
RMS_EPS = 1e-6
IN_SPLITS = (D_POOL, 2 * D_POOL, 2 * D_POOL + D_SSM, 2 * D_POOL + 2 * D_SSM,
             2 * D_POOL + 2 * D_SSM + D_MODEL)
IN_COLS = 2 * D_POOL + 2 * D_SSM + 2 * D_MODEL

kernel_name = 'hybrid_pool_s5_gated_block'


def rmsnorm(x, gain):
    xf = x.astype(jnp.float32)
    y = xf * lax.rsqrt(jnp.mean(xf * xf, axis=-1, keepdims=True) + RMS_EPS)
    return (y * gain.astype(jnp.float32)).astype(x.dtype)


def causal_pool_mixer(u, pool_w, pool_scale):
    bsz, seq, _ = u.shape
    uf = u.astype(jnp.float32)
    csum = jnp.cumsum(uf, axis=1)
    pos = jnp.arange(1, seq + 1, dtype=jnp.float32)[None, :, None]
    pooled = []
    for g, w in enumerate(POOL_WINDOWS):
        cs = csum[..., g * POOL_GROUP_WIDTH:(g + 1) * POOL_GROUP_WIDTH]
        lagged = jnp.pad(cs, ((0, 0), (w, 0), (0, 0)))[:, :seq]
        count = jnp.minimum(pos, float(w))
        pooled.append((cs - lagged) / count)
    pooled = (jnp.concatenate(pooled, axis=-1) - uf).astype(u.dtype)
    pooled = pooled.reshape(bsz, seq, POOL_GROUPS, POOL_GROUP_WIDTH)
    mixed = jnp.einsum('blgc,gcd->blgd', pooled, pool_w).reshape(bsz, seq, D_POOL)
    return mixed * pool_scale


def _complex_linear_combine(e1, e2):
    ar1, ai1, br1, bi1 = e1
    ar2, ai2, br2, bi2 = e2
    ar = ar2 * ar1 - ai2 * ai1
    ai = ar2 * ai1 + ai2 * ar1
    br = ar2 * br1 - ai2 * bi1 + br2
    bi = ar2 * bi1 + ai2 * br1 + bi2
    return (ar, ai, br, bi)


def s5_mixer(u, a_re, a_im, log_dt, b_re, b_im, c_re, c_im, d_skip, glu_w, glu_b):
    bsz, seq, _ = u.shape
    uf = u.astype(jnp.float32).reshape(bsz, seq, SSM_GROUPS, SSM_GROUP)
    dt = jnp.exp(log_dt.astype(jnp.float32))[:, None]
    lam_re = jnp.minimum(a_re.astype(jnp.float32), -1e-4)
    lam_im = a_im.astype(jnp.float32)
    mag = jnp.exp(lam_re * dt)
    abar_re = mag * jnp.cos(lam_im * dt)
    abar_im = mag * jnp.sin(lam_im * dt)
    den = lam_re * lam_re + lam_im * lam_im
    num_re = abar_re - 1.0
    f_re = (num_re * lam_re + abar_im * lam_im) / den
    f_im = (abar_im * lam_re - num_re * lam_im) / den
    f_re, f_im = f_re[:, :, None], f_im[:, :, None]
    bb_re = f_re * b_re - f_im * b_im
    bb_im = f_re * b_im + f_im * b_re
    bu_re = jnp.einsum('blgh,gph->blgp', uf, bb_re)
    bu_im = jnp.einsum('blgh,gph->blgp', uf, bb_im)
    a_seq_re = jnp.broadcast_to(abar_re[None, None], (1, seq, SSM_GROUPS, SSM_STATE))
    a_seq_im = jnp.broadcast_to(abar_im[None, None], (1, seq, SSM_GROUPS, SSM_STATE))
    _, _, s_re, s_im = lax.associative_scan(
        _complex_linear_combine, (a_seq_re, a_seq_im, bu_re, bu_im), axis=1)
    y = (jnp.einsum('blgp,ghp->blgh', s_re, c_re)
         - jnp.einsum('blgp,ghp->blgh', s_im, c_im)
         + d_skip * uf)
    y = jax.nn.gelu(y.reshape(bsz, seq, D_SSM).astype(u.dtype))
    return y * jax.nn.sigmoid(y @ glu_w + glu_b)


def hybrid_layer(x, c, w_ada, b_ada, norm_pre, norm_post, w_in, pool_w, pool_scale,
                 a_re, a_im, log_dt, b_re, b_im, c_re, c_im, d_skip, glu_w, glu_b,
                 w_branch_pool, w_branch_ssm, w_out):
    mod = jax.nn.silu(c) @ w_ada + b_ada
    shift, scale, gate = jnp.split(mod, 3, axis=-1)
    h = rmsnorm(x, norm_pre) * (1.0 + scale[:, None, :]) + shift[:, None, :]
    proj = h @ w_in
    u_pool, z_pool, u_ssm, z_ssm, g_pool, g_ssm = jnp.split(proj, list(IN_SPLITS), axis=-1)
    y_pool = causal_pool_mixer(u_pool, pool_w, pool_scale) * jax.nn.silu(z_pool)
    y_ssm = s5_mixer(u_ssm, a_re, a_im, log_dt, b_re, b_im, c_re, c_im, d_skip,
                     glu_w, glu_b) * jax.nn.silu(z_ssm)
    merged = (jax.nn.sigmoid(g_pool) * (y_pool @ w_branch_pool)
              + jax.nn.sigmoid(g_ssm) * (y_ssm @ w_branch_ssm))
    out = merged @ w_out
    return x + gate[:, None, :] * rmsnorm(out, norm_post)


def setup_inputs(seed: int = 0) -> dict:
    key = jax.random.key(seed)
    ks = jax.random.split(key, 24)
    f32 = jnp.float32

    def nrm(k, shape, s):
        return jax.random.normal(k, shape, f32) * s

    G, P, H = SSM_GROUPS, SSM_STATE, SSM_GROUP
    n_idx = jnp.arange(P, dtype=f32)
    return {
        'x': nrm(ks[0], (BATCH, SEQ, D_MODEL), 1.0),
        'c': nrm(ks[1], (BATCH, D_MODEL), 1.0),
        'w_ada': nrm(ks[2], (DEPTH, D_MODEL, 3 * D_MODEL), 0.5 * D_MODEL ** -0.5),
        'b_ada': nrm(ks[3], (DEPTH, 3 * D_MODEL), 0.02),
        'norm_pre': 1.0 + nrm(ks[4], (DEPTH, D_MODEL), 0.02),
        'norm_post': 1.0 + nrm(ks[5], (DEPTH, D_MODEL), 0.02),
        'w_in': nrm(ks[6], (DEPTH, D_MODEL, IN_COLS), D_MODEL ** -0.5),
        'pool_w': nrm(ks[7], (DEPTH, POOL_GROUPS, POOL_GROUP_WIDTH, POOL_GROUP_WIDTH),
                      POOL_GROUP_WIDTH ** -0.5),
        'pool_scale': 1.0 + nrm(ks[8], (DEPTH, D_POOL), 0.02),
        'ssm_a_re': -0.5 + nrm(ks[9], (DEPTH, G, P), 0.01),
        'ssm_a_im': math.pi * n_idx + nrm(ks[10], (DEPTH, G, P), 0.01),
        'ssm_log_dt': jax.random.uniform(ks[11], (DEPTH, G), f32,
                                         math.log(DT_MIN), math.log(DT_MAX)),
        'ssm_b_re': nrm(ks[12], (DEPTH, G, P, H), (2 * H) ** -0.5),
        'ssm_b_im': nrm(ks[13], (DEPTH, G, P, H), (2 * H) ** -0.5),
        'ssm_c_re': nrm(ks[14], (DEPTH, G, H, P), P ** -0.5),
        'ssm_c_im': nrm(ks[15], (DEPTH, G, H, P), P ** -0.5),
        'ssm_d': nrm(ks[16], (DEPTH, G, H), 0.5),
        'glu_w': nrm(ks[17], (DEPTH, D_SSM, D_SSM), D_SSM ** -0.5),
        'glu_b': nrm(ks[18], (DEPTH, D_SSM), 0.02),
        'w_branch_pool': nrm(ks[19], (DEPTH, D_POOL, D_MODEL), D_POOL ** -0.5),
        'w_branch_ssm': nrm(ks[20], (DEPTH, D_SSM, D_MODEL), D_SSM ** -0.5),
        'w_out': nrm(ks[21], (DEPTH, D_MODEL, D_MODEL), D_MODEL ** -0.5),
    }


def reference(x, c, w_ada, b_ada, norm_pre, norm_post, w_in, pool_w, pool_scale,
              ssm_a_re, ssm_a_im, ssm_log_dt, ssm_b_re, ssm_b_im, ssm_c_re, ssm_c_im,
              ssm_d, glu_w, glu_b, w_branch_pool, w_branch_ssm, w_out):
    for layer in range(DEPTH):
        x = hybrid_layer(x, c, w_ada[layer], b_ada[layer], norm_pre[layer], norm_post[layer],
                         w_in[layer], pool_w[layer], pool_scale[layer],
                         ssm_a_re[layer], ssm_a_im[layer], ssm_log_dt[layer],
                         ssm_b_re[layer], ssm_b_im[layer], ssm_c_re[layer], ssm_c_im[layer],
                         ssm_d[layer], glu_w[layer], glu_b[layer],
                         w_branch_pool[layer], w_branch_ssm[layer], w_out[layer])
    return x
```

```cpp
#include <hip/hip_runtime.h>
#include <hip/hip_cooperative_groups.h>
#include <cstdio>
#include <cstdint>
namespace cg = cooperative_groups;

#ifndef MK_USE_CG
#define MK_USE_CG 1
#endif
#ifndef MK_SPLIT
#define MK_SPLIT 0
#endif

namespace pg8 {
#define PG8_LAS __attribute__((address_space(3)))
typedef unsigned short bf16_t;
typedef short bf16x8 __attribute__((ext_vector_type(8)));
typedef float f32x4 __attribute__((ext_vector_type(4)));
typedef unsigned u32x4 __attribute__((ext_vector_type(4)));
constexpr int BM = 256, BK = 64, HALF = 128, HTB = HALF * BK * 2, STAGE_BYTES = 8 * HTB, NXCD = 8, WGM = 8;

__host__ __device__ __forceinline__ int lds_byte(int r, int c) { const int st = (r >> 4) * 2 + (c >> 5), rr = r & 15, cc = c & 31, ob = rr * 64 + cc * 2; return st * 1024 + (ob ^ (((ob >> 9) & 1) << 5)); }
__host__ __device__ __forceinline__ void stage_rc(int b, int& R, int& C) { const int st = b / 1024, sb = b % 1024, swz = sb ^ (((sb >> 9) & 1) << 5); R = (st >> 1) * 16 + swz / 64; C = (st & 1) * 32 + (swz % 64) / 2; }
__host__ __device__ __forceinline__ int perm32(int rho) { const int n = rho >> 4, i = rho & 15; return 8 * (i >> 2) + 4 * n + (i & 3); }

struct Unit { const char* a; const char* b; int pm, pn, g, half; };

__device__ __forceinline__ unsigned cvt_pk_bf16(float lo, float hi) { unsigned r; asm volatile("v_cvt_pk_bf16_f32 %0, %1, %2" : "=v"(r) : "v"(lo), "v"(hi)); return r; }
__device__ __forceinline__ u32x4 pack8(f32x4 v0, f32x4 v1) { u32x4 w; w.x = cvt_pk_bf16(v0[0], v0[1]); w.y = cvt_pk_bf16(v0[2], v0[3]); w.z = cvt_pk_bf16(v1[0], v1[1]); w.w = cvt_pk_bf16(v1[2], v1[3]); return w; }
__device__ __forceinline__ void unpack8(u32x4 w, f32x4& v0, f32x4& v1) {
    v0[0] = __uint_as_float(w.x << 16); v0[1] = __uint_as_float(w.x & 0xffff0000u); v0[2] = __uint_as_float(w.y << 16); v0[3] = __uint_as_float(w.y & 0xffff0000u);
    v1[0] = __uint_as_float(w.z << 16); v1[1] = __uint_as_float(w.z & 0xffff0000u); v1[2] = __uint_as_float(w.w << 16); v1[3] = __uint_as_float(w.w & 0xffff0000u); }
__device__ __forceinline__ float sigm(float x) { return __builtin_amdgcn_rcpf(1.f + __expf(-x)); }

typedef f32x4 Acc[2][2][4][2];

template <class Epi, class Sched, int LDA, int LDB, int KK>
__device__ __forceinline__ void gemm_phase(PG8_LAS unsigned char* lds, const Sched& S, const Epi& E) {
    const int tid = threadIdx.x, wid = __builtin_amdgcn_readfirstlane(tid >> 6), lane = tid & 63, wr = wid >> 2, wc = wid & 3, fr = lane & 15, fq = lane >> 4;
    constexpr int nt = KK / BK;
    unsigned voffA[2], voffB[2];
#pragma unroll
    for (int i = 0; i < 2; ++i) { int R, C; stage_rc(tid * 16 + i * 8192, R, C); const int Rb = (R & ~31) + perm32(R & 31);
        voffA[i] = (unsigned)(R * LDA + C) * 2u; voffB[i] = (unsigned)(Rb * LDB + C) * 2u; }
    constexpr size_t kstep = (size_t)(BK * 2);
    constexpr size_t hstepA = (size_t)HALF * LDA * 2, hstepB = (size_t)HALF * LDB * 2;
    const unsigned ldsw = (unsigned)wid * 1024u;
    const int aoff = lds_byte(wr * 64 + fr, fq * 8), boff = lds_byte(wc * 32 + fr, fq * 8);
#define PG8_SA(b, h) (((b) * 2 + (h)) * HTB)
#define PG8_SB(b, h) ((4 + (b) * 2 + (h)) * HTB)
#define PG8_STAGE(bufoff, gbase, voff) do { _Pragma("unroll") for (int _i = 0; _i < 2; ++_i) \
        __builtin_amdgcn_global_load_lds((const unsigned*)((const char*)(gbase) + (voff)[_i]), (PG8_LAS unsigned*)(lds + (bufoff) + ldsw + _i * 8192), 16, 0, 0); } while (0)
#define PG8_LDA(dst, b, h) do { _Pragma("unroll") for (int m = 0; m < 4; ++m) _Pragma("unroll") for (int k = 0; k < 2; ++k) dst[m][k] = *(const PG8_LAS bf16x8*)(lds + PG8_SA(b, h) + aoff + m * 2048 + k * 1024); } while (0)
#define PG8_LDB(dst, b, h) do { _Pragma("unroll") for (int n = 0; n < 2; ++n) _Pragma("unroll") for (int k = 0; k < 2; ++k) dst[n][k] = *(const PG8_LAS bf16x8*)(lds + PG8_SB(b, h) + boff + n * 2048 + k * 1024); } while (0)
#define PG8_MMA(ai, bj, At, Bt) do { __builtin_amdgcn_s_setprio(1); _Pragma("unroll") for (int m = 0; m < 4; ++m) _Pragma("unroll") for (int n = 0; n < 2; ++n) _Pragma("unroll") for (int k = 0; k < 2; ++k) \
        acc[ai][bj][m][n] = __builtin_amdgcn_mfma_f32_16x16x32_bf16(Bt[n][k], At[m][k], acc[ai][bj][m][n], 0, 0, 0); __builtin_amdgcn_s_setprio(0); } while (0)
#define PG8_WAIT_V(n) asm volatile("s_waitcnt vmcnt(" #n ")" ::: "memory")
#define PG8_WAIT_L(n) asm volatile("s_waitcnt lgkmcnt(" #n ")" ::: "memory")
#define PG8_BAR __builtin_amdgcn_s_barrier()
#define PG8_SCHED __builtin_amdgcn_sched_barrier(0)
    Unit cur, nxt; int ui = 0;
    if (!S.next(0, cur)) return;
    Acc acc;
#pragma unroll
    for (int a = 0; a < 2; ++a)
#pragma unroll
        for (int b = 0; b < 2; ++b)
#pragma unroll
            for (int m = 0; m < 4; ++m)
#pragma unroll
                for (int n = 0; n < 2; ++n) acc[a][b][m][n] = (f32x4){0.f, 0.f, 0.f, 0.f};
    bf16x8 At[4][2], B0[2][2], B1[2][2];
    const char* cA = cur.a; const char* cB = cur.b;
    PG8_STAGE(PG8_SB(0, 0), cB, voffB); PG8_STAGE(PG8_SB(0, 1), cB + hstepB, voffB); PG8_STAGE(PG8_SA(0, 0), cA, voffA); PG8_STAGE(PG8_SA(0, 1), cA + hstepA, voffA);
    if (wr == 1) PG8_BAR;
    PG8_WAIT_V(2); PG8_BAR;
    PG8_STAGE(PG8_SB(1, 0), cB + kstep, voffB); PG8_STAGE(PG8_SA(1, 0), cA + kstep, voffA); PG8_STAGE(PG8_SB(1, 1), cB + hstepB + kstep, voffB);
    PG8_WAIT_V(6); PG8_BAR;
    for (;;) {
        const bool has_next = S.next(ui + 1, nxt);
        const char* nA = has_next ? nxt.a : cA; const char* nB = has_next ? nxt.b : cB;
#pragma nounroll
        for (int t = 0; t < nt; t += 2) {
            const bool last = (t == nt - 2);
            const char* a1 = cA + (size_t)(t + 1) * kstep;
            const char* a2 = last ? nA : cA + (size_t)(t + 2) * kstep; const char* b2 = last ? nB : cB + (size_t)(t + 2) * kstep;
            const char* a3 = a2 + kstep; const char* b3 = b2 + kstep;
            PG8_LDB(B0, 0, 0); PG8_LDB(B1, 0, 1); PG8_SCHED; PG8_LDA(At, 0, 0); PG8_STAGE(PG8_SA(1, 1), a1 + hstepA, voffA);
            PG8_WAIT_V(8); PG8_WAIT_L(0); PG8_BAR; PG8_MMA(0, 0, At, B0); PG8_MMA(0, 1, At, B1); PG8_BAR; PG8_SCHED;
            PG8_LDA(At, 0, 1); PG8_STAGE(PG8_SB(0, 0), b2, voffB); PG8_STAGE(PG8_SB(0, 1), b2 + hstepB, voffB); PG8_STAGE(PG8_SA(0, 0), a2, voffA);
            PG8_WAIT_V(8); PG8_WAIT_L(0); PG8_BAR; PG8_MMA(1, 0, At, B0); PG8_MMA(1, 1, At, B1); PG8_BAR; PG8_SCHED;
            PG8_LDB(B0, 1, 0); PG8_LDB(B1, 1, 1); PG8_SCHED; PG8_LDA(At, 1, 0); PG8_STAGE(PG8_SA(0, 1), a2 + hstepA, voffA);
            PG8_WAIT_V(8); PG8_WAIT_L(0); PG8_BAR; PG8_MMA(0, 0, At, B0); PG8_MMA(0, 1, At, B1); PG8_BAR; PG8_SCHED;
            PG8_LDA(At, 1, 1); PG8_STAGE(PG8_SB(1, 0), b3, voffB); PG8_STAGE(PG8_SB(1, 1), b3 + hstepB, voffB); PG8_STAGE(PG8_SA(1, 0), a3, voffA);
            PG8_WAIT_V(8); PG8_WAIT_L(0); PG8_BAR; PG8_MMA(1, 0, At, B0); PG8_MMA(1, 1, At, B1); PG8_BAR; PG8_SCHED;
        }
        if (wr == 0) PG8_BAR;
        const bool keep = E(acc, cur, wr, wc, fr, fq);
        if (!has_next) break;
        if (!keep) {
#pragma unroll
            for (int a = 0; a < 2; ++a)
#pragma unroll
                for (int b = 0; b < 2; ++b)
#pragma unroll
                    for (int m = 0; m < 4; ++m)
#pragma unroll
                        for (int n = 0; n < 2; ++n) acc[a][b][m][n] = (f32x4){0.f, 0.f, 0.f, 0.f};
        }
        cur = nxt; cA = nA; cB = nB; ++ui;
        if (wr == 1) PG8_BAR;
    }
    PG8_WAIT_V(0);
    PG8_BAR;
#undef PG8_SA
#undef PG8_SB
#undef PG8_STAGE
#undef PG8_LDA
#undef PG8_LDB
#undef PG8_MMA
#undef PG8_WAIT_V
#undef PG8_WAIT_L
#undef PG8_BAR
#undef PG8_SCHED
}

struct SchedTile {
    const char* A; const char* B; size_t tstepA, tstepB; int nM, nN, nwg, G, c;
    __device__ __forceinline__ void init(const void* A_, const void* B_, int lda, int ldb, int M, int N, int G_, int c_) {
        A = (const char*)A_; B = (const char*)B_; tstepA = (size_t)BM * lda * 2; tstepB = (size_t)BM * ldb * 2; nM = M / BM; nN = N / BM; nwg = nM * nN; G = G_; c = c_; }
    __device__ __forceinline__ bool tile(int i, int& pm, int& pn) const {
        const long L = (long)i * G + c; if (L >= nwg) return false;
        int wgid = (int)L; { const int q = nwg / NXCD, r = nwg % NXCD, xcd = wgid % NXCD, off = wgid / NXCD; wgid = (xcd < r ? xcd * (q + 1) : r * (q + 1) + (xcd - r) * q) + off; }
        const int nig = WGM * nN, gid = wgid / nig, fm = gid * WGM, gsz = (nM - fm) < WGM ? (nM - fm) : WGM;
        pm = fm + ((wgid % nig) % gsz); pn = (wgid % nig) / gsz; return true; }
    __device__ __forceinline__ bool next(int i, Unit& u) const {
        int pm, pn; if (!tile(i, pm, pn)) return false;
        u.pm = pm; u.pn = pn; u.g = 0; u.half = 0; u.a = A + (size_t)pm * tstepA; u.b = B + (size_t)pn * tstepB; return true; }
};
struct SchedDual {
    SchedTile t; const char* A2; const char* B2;
    __device__ __forceinline__ bool next(int i, Unit& u) const {
        int pm, pn; if (!t.tile(i >> 1, pm, pn)) return false;
        u.pm = pm; u.pn = pn; u.g = 0; u.half = i & 1;
        u.a = ((i & 1) ? A2 : t.A) + (size_t)pm * t.tstepA; u.b = ((i & 1) ? B2 : t.B) + (size_t)pn * t.tstepB; return true; }
};
struct SchedGrp {
    const char* A; const char* B; size_t gstepA, tstepA, gstepB; int G, c, nunits;
    __device__ __forceinline__ bool next(int i, Unit& u) const {
        const int L = i * G + c; if (L >= nunits) return false;
        u.g = L >> 2; u.pm = L & 3; u.pn = 0; u.half = 0; u.a = A + (size_t)u.g * gstepA + (size_t)u.pm * tstepA; u.b = B + (size_t)u.g * gstepB; return true; }
};
struct SchedMini {
    const char* PWT; const char* WIN16; int G, c;
    __device__ __forceinline__ bool next(int i, Unit& u) const {
        const int L = i * G + c; if (L >= 16) return false;
        u.pm = L >> 2; u.pn = L & 3; u.g = 0; u.half = 0; u.a = PWT + (size_t)u.pm * 256 * 256 * 2; u.b = WIN16 + ((size_t)u.pn * 256 * 1024 + (size_t)u.pm * 256) * 2; return true; }
};

struct EpiPlain {
    bf16_t* O; int ldc;
    __device__ __forceinline__ bool operator()(Acc& acc, const Unit& u, int wr, int wc, int fr, int fq) const {
        const int row0 = u.pm * BM + wr * 64 + fr, col0 = u.pn * BM + wc * 32 + 8 * fq;
#pragma unroll
        for (int ai = 0; ai < 2; ++ai)
#pragma unroll
            for (int m = 0; m < 4; ++m) { bf16_t* rowp = O + (size_t)(row0 + ai * HALF + m * 16) * ldc + col0;
#pragma unroll
                for (int bj = 0; bj < 2; ++bj) *(u32x4*)(rowp + bj * HALF) = pack8(acc[ai][bj][m][0], acc[ai][bj][m][1]); }
        return false;
    }
};
struct EpiIn {
    unsigned char* ws; unsigned char* outb;
    __device__ __forceinline__ bool operator()(Acc& acc, const Unit& u, int wr, int wc, int fr, int fq) const {
        const int sg = u.pn >> 2, mode = (sg == 1 || sg == 3) ? 1 : (sg >= 4 ? 2 : 0);
        const int row0 = u.pm * BM + wr * 64 + fr, col0 = (u.pn & 3) * BM + wc * 32 + 8 * fq;
        const size_t so = (sg == 0) ? ((size_t)80 << 20) : (sg == 1) ? ((size_t)112 << 20) : (sg == 2) ? ((size_t)144 << 20) : (sg == 3) ? ((size_t)192 << 20) : (sg == 4) ? ((size_t)224 << 20) : ((size_t)32 << 20);
        bf16_t* base = (bf16_t*)(((sg == 5) ? outb : ws) + so);
#pragma unroll
        for (int ai = 0; ai < 2; ++ai)
#pragma unroll
            for (int m = 0; m < 4; ++m) { const int row = row0 + ai * HALF + m * 16;
#pragma unroll
                for (int bj = 0; bj < 2; ++bj) { const int col = col0 + bj * HALF; f32x4 v0 = acc[ai][bj][m][0], v1 = acc[ai][bj][m][1];
#pragma unroll
                    for (int j = 0; j < 4; ++j) { const float s0 = sigm(v0[j]), s1 = sigm(v1[j]); v0[j] = mode == 0 ? v0[j] : (mode == 1 ? v0[j] * s0 : s0); v1[j] = mode == 0 ? v1[j] : (mode == 1 ? v1[j] * s1 : s1); }
                    const size_t off = (sg == 2) ? ((size_t)((col >> 4) * 1024 + (row >> 4)) * 384 + (size_t)((row & 15) * 16 + (col & 15))) : ((size_t)row * 1024 + col);
                    *(u32x4*)(base + off) = pack8(v0, v1); } }
        return false;
    }
};
struct EpiS {
    float* SL;
    __device__ __forceinline__ bool operator()(Acc& acc, const Unit& u, int wr, int wc, int fr, int fq) const {
        const int row0 = u.pm * BM + wr * 64 + fr, col0 = wc * 32 + 8 * fq;
#pragma unroll
        for (int ai = 0; ai < 2; ++ai)
#pragma unroll
            for (int m = 0; m < 4; ++m) { float* p = SL + ((size_t)(row0 + ai * HALF + m * 16) * 64 + u.g) * 128 + col0;
                *(f32x4*)p = acc[ai][0][m][0]; *(f32x4*)(p + 4) = acc[ai][0][m][1]; }
        return false;
    }
};
struct EpiY {
    const bf16_t* AS; const float* D; bf16_t* YG;
    __device__ __forceinline__ bool operator()(Acc& acc, const Unit& u, int wr, int wc, int fr, int fq) const {
        const int row0 = u.pm * BM + wr * 64 + fr, col0 = wc * 32 + 8 * fq, h0 = 8 * (fq & 1);
        const f32x4 d0 = *(const f32x4*)(D + u.g * 16 + h0), d1 = *(const f32x4*)(D + u.g * 16 + h0 + 4);
#pragma unroll
        for (int ai = 0; ai < 2; ++ai)
#pragma unroll
            for (int m = 0; m < 4; ++m) { const int cr = row0 + ai * HALF + m * 16;
#pragma unroll
                for (int bj = 0; bj < 2; ++bj) { const int col = col0 + bj * HALF, t = col >> 4;
                    const u32x4 uw = *(const u32x4*)(AS + ((size_t)(u.g * 1024 + cr)) * 384 + col); f32x4 u0, u1; unpack8(uw, u0, u1);
                    f32x4 v0 = acc[ai][bj][m][0] + d0 * u0, v1 = acc[ai][bj][m][1] + d1 * u1;
#pragma unroll
                    for (int j = 0; j < 4; ++j) { const float a = v0[j], b = v1[j];
                        v0[j] = a * sigm(1.5957691216f * (a + 0.044715f * a * a * a)); v1[j] = b * sigm(1.5957691216f * (b + 0.044715f * b * b * b)); }
                    *(u32x4*)(YG + (size_t)(cr * 16 + t) * 1024 + u.g * 16 + h0) = pack8(v0, v1); } }
        return false;
    }
};
struct EpiGlu {
    const bf16_t* YG; bf16_t* ZS; const float* bias;
    __device__ __forceinline__ bool operator()(Acc& acc, const Unit& u, int wr, int wc, int fr, int fq) const {
        const int row0 = u.pm * BM + wr * 64 + fr, col0 = u.pn * BM + wc * 32 + 8 * fq;
        f32x4 bv[2][2];
#pragma unroll
        for (int bj = 0; bj < 2; ++bj) { bv[bj][0] = *(const f32x4*)(bias + col0 + bj * HALF); bv[bj][1] = *(const f32x4*)(bias + col0 + bj * HALF + 4); }
#pragma unroll
        for (int ai = 0; ai < 2; ++ai)
#pragma unroll
            for (int m = 0; m < 4; ++m) { const size_t ro = (size_t)(row0 + ai * HALF + m * 16) * 1024 + col0;
#pragma unroll
                for (int bj = 0; bj < 2; ++bj) { f32x4 y0, y1, z0, z1; unpack8(*(const u32x4*)(YG + ro + bj * HALF), y0, y1); unpack8(*(const u32x4*)(ZS + ro + bj * HALF), z0, z1);
                    f32x4 v0 = acc[ai][bj][m][0] + bv[bj][0], v1 = acc[ai][bj][m][1] + bv[bj][1];
#pragma unroll
                    for (int j = 0; j < 4; ++j) { v0[j] = y0[j] * sigm(v0[j]) * z0[j]; v1[j] = y1[j] * sigm(v1[j]) * z1[j]; }
                    *(u32x4*)(ZS + ro + bj * HALF) = pack8(v0, v1); } }
        return false;
    }
};
struct EpiBr {
    const bf16_t* GP; const bf16_t* GS; bf16_t* MG;
    __device__ __forceinline__ bool operator()(Acc& acc, const Unit& u, int wr, int wc, int fr, int fq) const {
        const int row0 = u.pm * BM + wr * 64 + fr, col0 = u.pn * BM + wc * 32 + 8 * fq;
        const bool first = (u.half == 0);
#pragma unroll
        for (int ai = 0; ai < 2; ++ai)
#pragma unroll
            for (int m = 0; m < 4; ++m) { const size_t ro = (size_t)(row0 + ai * HALF + m * 16) * 1024 + col0;
#pragma unroll
                for (int bj = 0; bj < 2; ++bj) { f32x4 s0, s1; unpack8(*(const u32x4*)(GS + ro + bj * HALF), s0, s1);
                    if (first) { f32x4 p0, p1; unpack8(*(const u32x4*)(GP + ro + bj * HALF), p0, p1);
#pragma unroll
                        for (int j = 0; j < 4; ++j) { acc[ai][bj][m][0][j] *= p0[j] * __builtin_amdgcn_rcpf(s0[j]); acc[ai][bj][m][1][j] *= p1[j] * __builtin_amdgcn_rcpf(s1[j]); }
                    } else { *(u32x4*)(MG + ro + bj * HALF) = pack8(acc[ai][bj][m][0] * s0, acc[ai][bj][m][1] * s1); } } }
        return first;
    }
};
struct EpiOut {
    float* OUT; float* SSQ;
    __device__ __forceinline__ bool operator()(Acc& acc, const Unit& u, int wr, int wc, int fr, int fq) const {
        const int row0 = u.pm * BM + wr * 64 + fr, col0 = u.pn * BM + wc * 32 + 8 * fq;
#pragma unroll
        for (int ai = 0; ai < 2; ++ai)
#pragma unroll
            for (int m = 0; m < 4; ++m) { const int row = row0 + ai * HALF + m * 16; float* p = OUT + (size_t)row * 1024 + col0; float ss = 0.f;
#pragma unroll
                for (int bj = 0; bj < 2; ++bj) { const f32x4 a = acc[ai][bj][m][0], b = acc[ai][bj][m][1];
                    *(f32x4*)(p + bj * HALF) = a; *(f32x4*)(p + bj * HALF + 4) = b;
                    ss += (a[0] * a[0] + a[1] * a[1]) + (a[2] * a[2] + a[3] * a[3]) + (b[0] * b[0] + b[1] * b[1]) + (b[2] * b[2] + b[3] * b[3]); }
                ss += __shfl_xor(ss, 16); ss += __shfl_xor(ss, 32);
                if (fq == 0) SSQ[(size_t)row * 16 + u.pn * 4 + wc] = ss; }
        return false;
    }
};
}

constexpr int NWAVES = 8;
constexpr int BATCH = 2, T = 8192, D = 1024, M = BATCH * T, NIN = 6144;
constexpr int SG = 64, SP = 64, SH = 16, CH = 16, NCR = M / CH  , KY = 384;
constexpr float RMS_EPS = 1e-6f;
typedef unsigned short bf16;
typedef unsigned v4u __attribute__((ext_vector_type(4)));
typedef float f32x4 __attribute__((ext_vector_type(4)));
#define LAS __attribute__((address_space(3)))

constexpr size_t MiB = 1u << 20;
constexpr size_t WS_CTL = 0, CTL_ZERO_BYTES = 64 * 1024;
constexpr size_t WS_MODP = 1 * MiB;
constexpr size_t WS_MODF = WS_MODP + 256 * 1024;
constexpr size_t WS_A16 = WS_MODF + 64 * 1024;
constexpr size_t WS_SSQ = 2 * MiB;
constexpr size_t WS_WIN = 4 * MiB;
constexpr size_t WS_GLU = 16 * MiB, WS_WBP = 18 * MiB, WS_WBS = 20 * MiB, WS_WOUT = 22 * MiB;
constexpr size_t WS_PWT = 24 * MiB;
constexpr size_t WS_WIN16 = 25 * MiB;
constexpr size_t WS_BS = 28 * MiB;
constexpr size_t WS_BY = 36 * MiB;
constexpr size_t WS_H = 48 * MiB;
constexpr size_t WS_V = 80 * MiB;
constexpr size_t WS_ZP = 112 * MiB;
constexpr size_t WS_AS = 144 * MiB;
constexpr size_t WS_ZS = 192 * MiB;
constexpr size_t WS_GP = 224 * MiB;
constexpr size_t WS_END = 256 * MiB;

constexpr int LDS_BYTES = 147456;

struct Args { const float* in[22]; float* out; unsigned char* ws; int ph_lo, ph_hi; };

__device__ __forceinline__ unsigned f2bf(float f) { unsigned u = __builtin_bit_cast(unsigned, f); return (u + 0x7fffu + ((u >> 16) & 1u)) >> 16; }
__device__ __forceinline__ unsigned pk2(float lo, float hi) { return f2bf(lo) | (f2bf(hi) << 16); }
__device__ __forceinline__ float bflo(unsigned w) { return __uint_as_float(w << 16); }
__device__ __forceinline__ float bfhi(unsigned w) { return __uint_as_float(w & 0xffff0000u); }
__device__ __forceinline__ float wave_sum(float v) {
#pragma unroll
    for (int o = 1; o < 64; o <<= 1) v += __shfl_xor(v, o);
    return v;
}

__device__ __forceinline__ void p0_transpose_item(const float* W, int ldw, int nblk, bf16* WT, int ldt, int row_off, LAS float* scr, int item, int lane) {
    const int kb = item / nblk, nb = item % nblk, k0 = 64 * kb, n0 = 32 * nb;
#pragma unroll 8
    for (int i = 0; i < 32; ++i) { const int kk = 2 * i + (lane >> 5); scr[kk * 33 + (lane & 31)] = W[(size_t)(k0 + kk) * ldw + n0 + (lane & 31)]; }
    asm volatile("s_waitcnt lgkmcnt(0)" ::: "memory");
    const int c = lane & 7;
#pragma unroll
    for (int j = 0; j < 4; ++j) { const int n = (lane >> 3) + 8 * j; const LAS float* s = scr + (8 * c) * 33 + n;
        v4u o; o.x = pk2(s[0 * 33], s[1 * 33]); o.y = pk2(s[2 * 33], s[3 * 33]); o.z = pk2(s[4 * 33], s[5 * 33]); o.w = pk2(s[6 * 33], s[7 * 33]);
        *(v4u*)(WT + (size_t)(row_off + n0 + n) * ldt + k0 + 8 * c) = o; }
    asm volatile("s_waitcnt lgkmcnt(0)" ::: "memory");
}

__device__ __forceinline__ void ssm_setup(const Args& args, int g, LAS float* L, int tid) {
    LAS float* pwr = L;
    LAS float* pwi = L + 17 * 64;
    LAS float* bbr = L + 34 * 64;
    LAS float* bbi = bbr + 1024;
    LAS float* cre = bbi + 1024;
    LAS float* cim = cre + 1024;
    LAS float* KT = cim + 1024;
    const float* a_re = args.in[9]; const float* a_im = args.in[10]; const float* log_dt = args.in[11];
    const float* b_re = args.in[12]; const float* b_im = args.in[13]; const float* c_re = args.in[14]; const float* c_im = args.in[15];
    unsigned char* ws = args.ws;
    if (tid < 64) {
        const int p = tid;
        const float dt = expf(log_dt[g]);
        const float lr = fminf(a_re[g * 64 + p], -1e-4f), li = a_im[g * 64 + p];
        const float xr = lr * dt;
        const double thd = (double)li * (double)dt;
#pragma unroll 1
        for (int j = 0; j <= 16; ++j) {
            const double tj = thd * (double)j; const double kk = rint(tj * 0.15915494309189535); const float r = (float)(tj - kk * 6.283185307179586);
            const float mg = expf(xr * (float)j);
            pwr[j * 64 + p] = mg * cosf(r); pwi[j * 64 + p] = mg * sinf(r);
        }
        const double k1 = rint(thd * 0.15915494309189535); const float r1 = (float)(thd - k1 * 6.283185307179586);
        const float c1 = cosf(r1), s1 = sinf(r1), sh = sinf(0.5f * r1), mg1 = expf(xr);
        const float num_re = expm1f(xr) * c1 - 2.f * sh * sh, num_im = mg1 * s1;
        const float den = lr * lr + li * li;
        const float f_re = (num_re * lr + num_im * li) / den, f_im = (num_im * lr - num_re * li) / den;
#pragma unroll 4
        for (int h = 0; h < 16; ++h) { const float br = b_re[(g * 64 + p) * 16 + h], bi = b_im[(g * 64 + p) * 16 + h];
            bbr[p * 16 + h] = f_re * br - f_im * bi; bbi[p * 16 + h] = f_re * bi + f_im * br; }
    }
    for (int i = tid; i < 1024; i += 512) { cre[i] = c_re[g * 1024 + i]; cim[i] = c_im[g * 1024 + i]; }
    __syncthreads();
    if (tid < 64) { float* a16 = (float*)(ws + WS_A16); a16[(g * 64 + tid) * 2] = pwr[16 * 64 + tid]; a16[(g * 64 + tid) * 2 + 1] = pwi[16 * 64 + tid]; }
    {
        const int j = tid >> 5, h = (tid >> 1) & 15, hb = (tid & 1) * 8;
        float kacc[8];
#pragma unroll
        for (int i = 0; i < 8; ++i) kacc[i] = 0.f;
#pragma unroll 4
        for (int p = 0; p < 64; ++p) { const float cr = cre[h * 64 + p], ci = cim[h * 64 + p], pr = pwr[j * 64 + p], pi = pwi[j * 64 + p];
            const float ar = cr * pr - ci * pi, ai = cr * pi + ci * pr;
#pragma unroll
            for (int i = 0; i < 8; ++i) kacc[i] += ar * bbr[p * 16 + hb + i] - ai * bbi[p * 16 + hb + i]; }
#pragma unroll
        for (int i = 0; i < 8; ++i) KT[(j * 16 + h) * 16 + hb + i] = kacc[i];
    }
    __syncthreads();
    bf16* BY = (bf16*)(ws + WS_BY) + (size_t)g * 256 * KY;
    for (int v = tid; v < 256 * 48; v += 512) {
        const int n = v / 48, k0 = (v % 48) * 8, t = n >> 4, h = n & 15; float val[8];
        if (k0 < 256) { const int tp = k0 >> 4, hh0 = k0 & 15;
#pragma unroll
            for (int i = 0; i < 8; ++i) val[i] = (tp <= t) ? KT[((t - tp) * 16 + h) * 16 + hh0 + i] : 0.f;
        } else if (k0 < 320) { const int p0 = k0 - 256;
#pragma unroll
            for (int i = 0; i < 8; ++i) val[i] = cre[h * 64 + p0 + i] * pwr[(t + 1) * 64 + p0 + i] - cim[h * 64 + p0 + i] * pwi[(t + 1) * 64 + p0 + i];
        } else { const int p0 = k0 - 320;
#pragma unroll
            for (int i = 0; i < 8; ++i) val[i] = -(cre[h * 64 + p0 + i] * pwi[(t + 1) * 64 + p0 + i] + cim[h * 64 + p0 + i] * pwr[(t + 1) * 64 + p0 + i]);
        }
        v4u o; o.x = pk2(val[0], val[1]); o.y = pk2(val[2], val[3]); o.z = pk2(val[4], val[5]); o.w = pk2(val[6], val[7]);
        *(v4u*)(BY + (size_t)n * KY + k0) = o;
    }
    bf16* BS = (bf16*)(ws + WS_BS) + (size_t)g * 256 * 256;
    for (int v = tid; v < 256 * 32; v += 512) {
        const int n = v >> 5, k0 = (v & 31) * 8, t = k0 >> 4, hh0 = k0 & 15; float val[8];
        if (n < 128) { const int p = n & 63; const float pr = pwr[(15 - t) * 64 + p], pi = pwi[(15 - t) * 64 + p];
#pragma unroll
            for (int i = 0; i < 8; ++i) { const float br = bbr[p * 16 + hh0 + i], bi = bbi[p * 16 + hh0 + i]; val[i] = (n < 64) ? (pr * br - pi * bi) : (pr * bi + pi * br); }
        } else {
#pragma unroll
            for (int i = 0; i < 8; ++i) val[i] = 0.f;
        }
        v4u o; o.x = pk2(val[0], val[1]); o.y = pk2(val[2], val[3]); o.z = pk2(val[4], val[5]); o.w = pk2(val[6], val[7]);
        *(v4u*)(BS + (size_t)n * 256 + k0) = o;
    }
    __syncthreads();
}

__global__ void __launch_bounds__(NWAVES * 64, 2) fwd_megakernel(Args args) {
    extern __shared__ __attribute__((aligned(16))) unsigned char lds_raw[];
    LAS unsigned char* lds = (LAS unsigned char*)lds_raw;
    const int tid = threadIdx.x, lane = tid & 63, wave = __builtin_amdgcn_readfirstlane(tid >> 6);
    const int G = gridDim.x, bx = blockIdx.x;
    const int gw = bx * NWAVES + wave, NGW = G * NWAVES;
    unsigned char* ws = args.ws;
#if MK_SPLIT
    const int lo = args.ph_lo, hi = args.ph_hi;
#else
    constexpr int lo = 0, hi = 10;
#endif
#ifndef MK_PHASES
#define MK_PHASES 0x3ff
#endif
#define IN(k) (((MK_PHASES >> (k)) & 1) && lo <= (k) && (k) < hi)
#define GRID_BAR(k) do { if (IN(k) && IN((k) + 1)) { cg::this_grid().sync(); } } while (0)

    const float* x = args.in[0];
    bf16* WIN = (bf16*)(ws + WS_WIN); bf16* GLUT = (bf16*)(ws + WS_GLU); bf16* WBP = (bf16*)(ws + WS_WBP); bf16* WBS = (bf16*)(ws + WS_WBS); bf16* WOUT = (bf16*)(ws + WS_WOUT);
    bf16* PWT = (bf16*)(ws + WS_PWT); bf16* WIN16 = (bf16*)(ws + WS_WIN16);
    bf16* Hb = (bf16*)(ws + WS_H); bf16* Vb = (bf16*)(ws + WS_V); bf16* ZP = (bf16*)(ws + WS_ZP); bf16* AS = (bf16*)(ws + WS_AS); bf16* ZS = (bf16*)(ws + WS_ZS); bf16* GP = (bf16*)(ws + WS_GP);
    bf16* GS = (bf16*)((unsigned char*)args.out + 32 * MiB); float* SL = (float*)args.out;
    bf16* YP = Hb; bf16* YG = Vb; bf16* MG = ZP;
    float* MODP = (float*)(ws + WS_MODP); float* MODF = (float*)(ws + WS_MODF); float* A16 = (float*)(ws + WS_A16); float* SSQ = (float*)(ws + WS_SSQ);

    if (IN(0)) {
        if (bx < SG) ssm_setup(args, bx, (LAS float*)lds, tid);
        LAS float* scr = (LAS float*)(lds + wave * 16384);
        constexpr int I_IN = 16 * 160, I_SQ = 16 * 32, I_PW = 4 * 8;
        constexpr int NT = I_IN + 4 * I_SQ + 4 * I_PW, NCV = 1024, NGV = 48 * 8;
        for (int it = gw; it < NT + NCV + NGV; it += NGW) {
            int r = it;
            if (r < I_IN) { p0_transpose_item(args.in[6] + 1024, NIN, 160, WIN, 1024, 1024, scr, r, lane); continue; } r -= I_IN;
            if (r < I_SQ) { p0_transpose_item(args.in[17], 1024, 32, GLUT, 1024, 0, scr, r, lane); continue; } r -= I_SQ;
            if (r < I_SQ) { p0_transpose_item(args.in[19], 1024, 32, WBP, 1024, 0, scr, r, lane); continue; } r -= I_SQ;
            if (r < I_SQ) { p0_transpose_item(args.in[20], 1024, 32, WBS, 1024, 0, scr, r, lane); continue; } r -= I_SQ;
            if (r < I_SQ) { p0_transpose_item(args.in[21], 1024, 32, WOUT, 1024, 0, scr, r, lane); continue; } r -= I_SQ;
            if (r < 4 * I_PW) { const int pg = r / I_PW; p0_transpose_item(args.in[7] + (size_t)pg * 65536, 256, 8, PWT, 256, pg * 256, scr, r % I_PW, lane); continue; } r -= 4 * I_PW;
            if (r < NCV) {
                const float* src = args.in[6] + (size_t)r * NIN; bf16* dst = WIN16 + (size_t)r * 1024;
#pragma unroll
                for (int j = 0; j < 4; ++j) { const f32x4 v = *(const f32x4*)(src + 4 * lane + 256 * j);
                    *(unsigned long long*)(dst + 4 * lane + 256 * j) = (unsigned long long)pk2(v.x, v.y) | ((unsigned long long)pk2(v.z, v.w) << 32); }
                continue; } r -= NCV;
            {
                const int jb = r >> 3, ks = r & 7, j = jb * 64 + lane; const float* cc = args.in[1]; const float* wa = args.in[2];
                float p0 = 0.f, p1 = 0.f;
#pragma unroll 8
                for (int k = ks * 128; k < ks * 128 + 128; ++k) { const float c0 = cc[k], c1 = cc[1024 + k]; const float a0 = c0 * pg8::sigm(c0), a1 = c1 * pg8::sigm(c1);
                    const float w = wa[(size_t)k * 3072 + j]; p0 += a0 * w; p1 += a1 * w; }
                MODP[(ks * 2 + 0) * 3072 + j] = p0; MODP[(ks * 2 + 1) * 3072 + j] = p1;
            }
        }
    }
    GRID_BAR(0);

    if (IN(1)) {
        if (bx < 16) {
            pg8::SchedMini S{(const char*)PWT, (const char*)WIN16, G, bx}; pg8::EpiPlain E{WIN, 1024};
            pg8::gemm_phase<pg8::EpiPlain, pg8::SchedMini, 256, 1024, 256>(lds, S, E);
        }
        __syncthreads();
        LAS float* modl = (LAS float*)lds;
        for (int i = tid; i < 6144; i += 512) { const int j = i % 3072, b = i / 3072; float s = args.in[3][j];
#pragma unroll
            for (int ks = 0; ks < 8; ++ks) s += MODP[(ks * 2 + b) * 3072 + j];
            modl[i] = s; if (bx == 0) MODF[i] = s; }
        __syncthreads();
        const float* gain = args.in[4];
        for (int m = gw; m < M; m += NGW) {
            const int b = m >> 13; const float* xr = x + (size_t)m * D; f32x4 v[4]; float s = 0.f;
#pragma unroll
            for (int j = 0; j < 4; ++j) { v[j] = *(const f32x4*)(xr + 4 * lane + 256 * j); s += (v[j].x * v[j].x + v[j].y * v[j].y) + (v[j].z * v[j].z + v[j].w * v[j].w); }
            const float rstd = rsqrtf(wave_sum(s) * (1.f / D) + RMS_EPS);
#pragma unroll
            for (int j = 0; j < 4; ++j) { const int col = 4 * lane + 256 * j; const f32x4 gn = *(const f32x4*)(gain + col);
                const f32x4 sh = *(const LAS f32x4*)(modl + b * 3072 + col), sc = *(const LAS f32x4*)(modl + b * 3072 + 1024 + col);
                const f32x4 h = v[j] * rstd * gn * (sc + 1.f) + sh;
                *(unsigned long long*)(Hb + (size_t)m * D + col) = (unsigned long long)pk2(h.x, h.y) | ((unsigned long long)pk2(h.z, h.w) << 32); }
        }
        __syncthreads();
    }
    GRID_BAR(1);

    if (IN(2)) {
        pg8::SchedTile S; S.init(Hb, WIN, 1024, 1024, M, NIN, G, bx);
        pg8::EpiIn E{ws, (unsigned char*)args.out};
        static_assert(WS_V == (80u << 20) && WS_ZP == (112u << 20) && WS_AS == (144u << 20) && WS_ZS == (192u << 20) && WS_GP == (224u << 20), "EpiIn segment map");
        pg8::gemm_phase<pg8::EpiIn, pg8::SchedTile, 1024, 1024, 1024>(lds, S, E);
    }
    GRID_BAR(2);

    if (IN(3)) {
        pg8::SchedGrp S{(const char*)AS, (const char*)(ws + WS_BS), (size_t)NCR * KY * 2, (size_t)256 * KY * 2, (size_t)256 * 256 * 2, G, bx, 256};
        pg8::EpiS E{SL};
        pg8::gemm_phase<pg8::EpiS, pg8::SchedGrp, KY, 256, 256>(lds, S, E);
    }
    GRID_BAR(3);

    if (IN(4)) {
        for (int task = bx; task < 128; task += G) {
            if (wave == 0) {
                const int b = task >> 6, g = task & 63, p = lane;
                const float ar = A16[(g * 64 + p) * 2], ai = A16[(g * 64 + p) * 2 + 1];
                float sr = 0.f, si = 0.f;
                const float* sl = SL + ((size_t)(b * 512) * 64 + g) * 128 + p;
                bf16* as = AS + ((size_t)(g * 1024 + b * 512)) * KY + 256 + p;
#pragma unroll 8
                for (int c = 0; c < 512; ++c) {
                    const float lr = sl[(size_t)c * 64 * 128], li = sl[(size_t)c * 64 * 128 + 64];
                    as[(size_t)c * KY] = (bf16)f2bf(sr); as[(size_t)c * KY + 64] = (bf16)f2bf(si);
                    const float nr = ar * sr - ai * si + lr, ni = ar * si + ai * sr + li; sr = nr; si = ni;
                }
            }
        }
        const float* pscale = args.in[8];
        for (int task = ((gw + NGW - 128 * NWAVES) % NGW); task < 1024; task += NGW) {
            const int seg = task >> 1, hf = task & 1, ch0 = hf * 512 + lane * 8, gi = ch0 >> 8, w = 2 << gi;
            const int m0 = seg * 32, tb = m0 & (T - 1);
            float s[8];
#pragma unroll
            for (int i = 0; i < 8; ++i) s[i] = 0.f;
            for (int d = 1; d <= 16; ++d) if (d <= w && tb - d >= 0) { const v4u q = *(const v4u*)(Vb + (size_t)(m0 - d) * D + ch0);
                s[0] += bflo(q.x); s[1] += bfhi(q.x); s[2] += bflo(q.y); s[3] += bfhi(q.y); s[4] += bflo(q.z); s[5] += bfhi(q.z); s[6] += bflo(q.w); s[7] += bfhi(q.w); }
            const f32x4 ps0 = *(const f32x4*)(pscale + ch0), ps1 = *(const f32x4*)(pscale + ch0 + 4);
            const float psc[8] = {ps0.x, ps0.y, ps0.z, ps0.w, ps1.x, ps1.y, ps1.z, ps1.w};
#pragma unroll 4
            for (int i = 0; i < 32; ++i) {
                const int m = m0 + i, t = tb + i;
                const v4u q = *(const v4u*)(Vb + (size_t)m * D + ch0); const v4u z = *(const v4u*)(ZP + (size_t)m * D + ch0);
                float v[8] = {bflo(q.x), bfhi(q.x), bflo(q.y), bfhi(q.y), bflo(q.z), bfhi(q.z), bflo(q.w), bfhi(q.w)};
                const float zz[8] = {bflo(z.x), bfhi(z.x), bflo(z.y), bfhi(z.y), bflo(z.z), bfhi(z.z), bflo(z.w), bfhi(z.w)};
#pragma unroll
                for (int k = 0; k < 8; ++k) s[k] += v[k];
                if (t >= w) { const v4u o = *(const v4u*)(Vb + (size_t)(m - w) * D + ch0);
                    s[0] -= bflo(o.x); s[1] -= bfhi(o.x); s[2] -= bflo(o.y); s[3] -= bfhi(o.y); s[4] -= bflo(o.z); s[5] -= bfhi(o.z); s[6] -= bflo(o.w); s[7] -= bfhi(o.w); }
                const float inv = 1.f / (float)((t + 1 < w) ? (t + 1) : w);
                float r[8];
#pragma unroll
                for (int k = 0; k < 8; ++k) r[k] = (s[k] * inv - v[k]) * psc[k] * zz[k];
                v4u o; o.x = pk2(r[0], r[1]); o.y = pk2(r[2], r[3]); o.z = pk2(r[4], r[5]); o.w = pk2(r[6], r[7]);
                *(v4u*)(YP + (size_t)m * D + ch0) = o;
            }
        }
    }
    GRID_BAR(4);

    if (IN(5)) {
        pg8::SchedGrp S{(const char*)AS, (const char*)(ws + WS_BY), (size_t)NCR * KY * 2, (size_t)256 * KY * 2, (size_t)256 * KY * 2, G, bx, 256};
        pg8::EpiY E{AS, args.in[16], YG};
        pg8::gemm_phase<pg8::EpiY, pg8::SchedGrp, KY, KY, KY>(lds, S, E);
    }
    GRID_BAR(5);

    if (IN(6)) {
        pg8::SchedTile S; S.init(YG, GLUT, 1024, 1024, M, D, G, bx);
        pg8::EpiGlu E{YG, ZS, args.in[18]};
        pg8::gemm_phase<pg8::EpiGlu, pg8::SchedTile, 1024, 1024, 1024>(lds, S, E);
    }
    GRID_BAR(6);

    if (IN(7)) {
        pg8::SchedDual S; S.t.init(YP, WBP, 1024, 1024, M, D, G, bx); S.A2 = (const char*)ZS; S.B2 = (const char*)WBS;
        pg8::EpiBr E{GP, GS, MG};
        pg8::gemm_phase<pg8::EpiBr, pg8::SchedDual, 1024, 1024, 1024>(lds, S, E);
    }
    GRID_BAR(7);

    if (IN(8)) {
        pg8::SchedTile S; S.init(MG, WOUT, 1024, 1024, M, D, G, bx);
        pg8::EpiOut E{args.out, SSQ};
        pg8::gemm_phase<pg8::EpiOut, pg8::SchedTile, 1024, 1024, 1024>(lds, S, E);
    }
    GRID_BAR(8);

    if (IN(9)) {
        const float* npost = args.in[5];
        for (int m = gw; m < M; m += NGW) {
            const int b = m >> 13;
            float ss = (lane < 16) ? SSQ[(size_t)m * 16 + lane] : 0.f;
            ss = wave_sum(ss);
            const float rstd = rsqrtf(ss * (1.f / D) + RMS_EPS);
            const float* xr = x + (size_t)m * D; float* orow = args.out + (size_t)m * D;
#pragma unroll
            for (int j = 0; j < 4; ++j) { const int col = 4 * lane + 256 * j;
                const f32x4 xv = *(const f32x4*)(xr + col), ov = *(const f32x4*)(orow + col), gn = *(const f32x4*)(npost + col), gt = *(const f32x4*)(MODF + b * 3072 + 2048 + col);
                *(f32x4*)(orow + col) = xv + gt * (ov * rstd * gn); }
        }
    }
#undef IN
#undef GRID_BAR
}

extern "C" void kernel_launch(void* const* d_in, const int* in_sizes, int n_in, void* d_out, int out_size, void* d_ws, size_t ws_size, hipStream_t stream) {
    static int grid = 0;
    if (grid == 0) {
        if (n_in != 22 || in_sizes[0] != M * D || out_size != M * D || ws_size < WS_END) { fprintf(stderr, "kernel_launch: unexpected shapes (n_in %d, in0 %d, out %d, ws %zu); nothing launched\n", n_in, n_in > 0 ? in_sizes[0] : -1, out_size, ws_size); grid = -1; return; }
        int dev = 0, cus = 0, per_cu = 0;
        if (hipGetDevice(&dev) != hipSuccess || hipDeviceGetAttribute(&cus, hipDeviceAttributeMultiprocessorCount, dev) != hipSuccess) { grid = -1; return; }
        if (hipFuncSetAttribute((const void*)fwd_megakernel, hipFuncAttributeMaxDynamicSharedMemorySize, LDS_BYTES) != hipSuccess) { fprintf(stderr, "kernel_launch: hipFuncSetAttribute failed\n"); grid = -1; return; }
        if (hipOccupancyMaxActiveBlocksPerMultiprocessor(&per_cu, (const void*)fwd_megakernel, NWAVES * 64, LDS_BYTES) != hipSuccess || per_cu < 1) { fprintf(stderr, "kernel_launch: occupancy query says %d\n", per_cu); per_cu = 1; }
        (void)hipGetLastError();
        grid = cus;
    }
    if (grid < 0) return;
    Args a{};
    for (int i = 0; i < 22; ++i) a.in[i] = (const float*)d_in[i];
    a.out = (float*)d_out; a.ws = (unsigned char*)d_ws;
#if MK_SPLIT
    for (int ph = 0; ph < 10; ++ph) {
        a.ph_lo = ph; a.ph_hi = ph + 1; void* kargs[] = {&a};
        hipError_t e = hipLaunchCooperativeKernel((const void*)fwd_megakernel, dim3(grid), dim3(NWAVES * 64), kargs, LDS_BYTES, stream);
        if (e != hipSuccess) { fprintf(stderr, "kernel_launch: cooperative launch (phase %d) failed: %s\n", ph, hipGetErrorString(e)); break; }
    }
#else
    a.ph_lo = 0; a.ph_hi = 10; void* kargs[] = {&a};
    hipError_t e = hipLaunchCooperativeKernel((const void*)fwd_megakernel, dim3(grid), dim3(NWAVES * 64), kargs, LDS_BYTES, stream);
    if (e != hipSuccess) fprintf(stderr, "kernel_launch: cooperative launch failed: %s (grid %d)\n", hipGetErrorString(e), grid);
#endif
}
```

```cpp
#include <hip/hip_runtime.h>
#include <hip/hip_cooperative_groups.h>
#include <cstdio>
#include <cstdint>
namespace cg = cooperative_groups;

#ifndef MK_USE_CG
#define MK_USE_CG 0
#endif
#ifndef MK_SPLIT
#define MK_SPLIT 0
#endif

namespace pg8 {
#define PG8_LAS __attribute__((address_space(3)))
typedef unsigned short bf16_t;
typedef short bf16x8 __attribute__((ext_vector_type(8)));
typedef float f32x4 __attribute__((ext_vector_type(4)));
typedef unsigned u32x4 __attribute__((ext_vector_type(4)));
constexpr int BM = 256, BK = 64, HALF = 128, HTB = HALF * BK * 2, STAGE_BYTES = 8 * HTB, NXCD = 8, WGM = 8;

__host__ __device__ __forceinline__ int lds_byte(int r, int c) { const int st = (r >> 4) * 2 + (c >> 5), rr = r & 15, cc = c & 31, ob = rr * 64 + cc * 2; return st * 1024 + (ob ^ (((ob >> 9) & 1) << 5)); }
__host__ __device__ __forceinline__ void stage_rc(int b, int& R, int& C) { const int st = b / 1024, sb = b % 1024, swz = sb ^ (((sb >> 9) & 1) << 5); R = (st >> 1) * 16 + swz / 64; C = (st & 1) * 32 + (swz % 64) / 2; }
__host__ __device__ __forceinline__ int perm32(int rho) { const int n = rho >> 4, i = rho & 15; return 8 * (i >> 2) + 4 * n + (i & 3); }

struct Unit { const char* a; const char* b; int pm, pn, g, half; };

__device__ __forceinline__ unsigned cvt_pk_bf16(float lo, float hi) { unsigned r; asm volatile("v_cvt_pk_bf16_f32 %0, %1, %2" : "=v"(r) : "v"(lo), "v"(hi)); return r; }
__device__ __forceinline__ u32x4 pack8(f32x4 v0, f32x4 v1) { u32x4 w; w.x = cvt_pk_bf16(v0[0], v0[1]); w.y = cvt_pk_bf16(v0[2], v0[3]); w.z = cvt_pk_bf16(v1[0], v1[1]); w.w = cvt_pk_bf16(v1[2], v1[3]); return w; }
__device__ __forceinline__ void unpack8(u32x4 w, f32x4& v0, f32x4& v1) {
    v0[0] = __uint_as_float(w.x << 16); v0[1] = __uint_as_float(w.x & 0xffff0000u); v0[2] = __uint_as_float(w.y << 16); v0[3] = __uint_as_float(w.y & 0xffff0000u);
    v1[0] = __uint_as_float(w.z << 16); v1[1] = __uint_as_float(w.z & 0xffff0000u); v1[2] = __uint_as_float(w.w << 16); v1[3] = __uint_as_float(w.w & 0xffff0000u); }
__device__ __forceinline__ float sigm(float x) { return __builtin_amdgcn_rcpf(1.f + __expf(-x)); }

typedef f32x4 Acc[2][2][4][2];

template <class Epi, class Sched, int LDA, int LDB, int KK>
__device__ __forceinline__ void gemm_phase(PG8_LAS unsigned char* lds, const Sched& S, const Epi& E) {
    const int tid = threadIdx.x, wid = __builtin_amdgcn_readfirstlane(tid >> 6), lane = tid & 63, wr = wid >> 2, wc = wid & 3, fr = lane & 15, fq = lane >> 4;
    constexpr int nt = KK / BK;
    unsigned voffA[2], voffB[2];
#pragma unroll
    for (int i = 0; i < 2; ++i) { int R, C; stage_rc(tid * 16 + i * 8192, R, C); const int Rb = (R & ~31) + perm32(R & 31);
        voffA[i] = (unsigned)(R * LDA + C) * 2u; voffB[i] = (unsigned)(Rb * LDB + C) * 2u; }
    constexpr size_t kstep = (size_t)(BK * 2);
    constexpr size_t hstepA = (size_t)HALF * LDA * 2, hstepB = (size_t)HALF * LDB * 2;
    const unsigned ldsw = (unsigned)wid * 1024u;
    const int aoff = lds_byte(wr * 64 + fr, fq * 8), boff = lds_byte(wc * 32 + fr, fq * 8);
#define PG8_SA(b, h) (((b) * 2 + (h)) * HTB)
#define PG8_SB(b, h) ((4 + (b) * 2 + (h)) * HTB)
#define PG8_STAGE(bufoff, gbase, voff) do { _Pragma("unroll") for (int _i = 0; _i < 2; ++_i) \
        __builtin_amdgcn_global_load_lds((const unsigned*)((const char*)(gbase) + (voff)[_i]), (PG8_LAS unsigned*)(lds + (bufoff) + ldsw + _i * 8192), 16, 0, 0); } while (0)
#define PG8_LDA(dst, b, h) do { _Pragma("unroll") for (int m = 0; m < 4; ++m) _Pragma("unroll") for (int k = 0; k < 2; ++k) dst[m][k] = *(const PG8_LAS bf16x8*)(lds + PG8_SA(b, h) + aoff + m * 2048 + k * 1024); } while (0)
#define PG8_LDB(dst, b, h) do { _Pragma("unroll") for (int n = 0; n < 2; ++n) _Pragma("unroll") for (int k = 0; k < 2; ++k) dst[n][k] = *(const PG8_LAS bf16x8*)(lds + PG8_SB(b, h) + boff + n * 2048 + k * 1024); } while (0)
#define PG8_MMA(ai, bj, At, Bt) do { __builtin_amdgcn_s_setprio(1); _Pragma("unroll") for (int m = 0; m < 4; ++m) _Pragma("unroll") for (int n = 0; n < 2; ++n) _Pragma("unroll") for (int k = 0; k < 2; ++k) \
        acc[ai][bj][m][n] = __builtin_amdgcn_mfma_f32_16x16x32_bf16(Bt[n][k], At[m][k], acc[ai][bj][m][n], 0, 0, 0); __builtin_amdgcn_s_setprio(0); } while (0)
#define PG8_WAIT_V(n) asm volatile("s_waitcnt vmcnt(" #n ")" ::: "memory")
#define PG8_WAIT_L(n) asm volatile("s_waitcnt lgkmcnt(" #n ")" ::: "memory")
#define PG8_BAR __builtin_amdgcn_s_barrier()
#define PG8_SCHED __builtin_amdgcn_sched_barrier(0)
    Unit cur, nxt; int ui = 0;
    if (!S.next(0, cur)) return;
    Acc acc;
#pragma unroll
    for (int a = 0; a < 2; ++a)
#pragma unroll
        for (int b = 0; b < 2; ++b)
#pragma unroll
            for (int m = 0; m < 4; ++m)
#pragma unroll
                for (int n = 0; n < 2; ++n) acc[a][b][m][n] = (f32x4){0.f, 0.f, 0.f, 0.f};
    bf16x8 At[4][2], B0[2][2], B1[2][2];
    const char* cA = cur.a; const char* cB = cur.b;
    PG8_STAGE(PG8_SB(0, 0), cB, voffB); PG8_STAGE(PG8_SB(0, 1), cB + hstepB, voffB); PG8_STAGE(PG8_SA(0, 0), cA, voffA); PG8_STAGE(PG8_SA(0, 1), cA + hstepA, voffA);
    if (wr == 1) PG8_BAR;
    PG8_WAIT_V(2); PG8_BAR;
    PG8_STAGE(PG8_SB(1, 0), cB + kstep, voffB); PG8_STAGE(PG8_SA(1, 0), cA + kstep, voffA); PG8_STAGE(PG8_SB(1, 1), cB + hstepB + kstep, voffB);
    PG8_WAIT_V(6); PG8_BAR;
    for (;;) {
        const bool has_next = S.next(ui + 1, nxt);
        const char* nA = has_next ? nxt.a : cA; const char* nB = has_next ? nxt.b : cB;
#pragma nounroll
        for (int t = 0; t < nt; t += 2) {
            const bool last = (t == nt - 2);
            const char* a1 = cA + (size_t)(t + 1) * kstep;
            const char* a2 = last ? nA : cA + (size_t)(t + 2) * kstep; const char* b2 = last ? nB : cB + (size_t)(t + 2) * kstep;
            const char* a3 = a2 + kstep; const char* b3 = b2 + kstep;
            PG8_LDB(B0, 0, 0); PG8_LDB(B1, 0, 1); PG8_SCHED; PG8_LDA(At, 0, 0); PG8_STAGE(PG8_SA(1, 1), a1 + hstepA, voffA);
            PG8_WAIT_V(8); PG8_WAIT_L(0); PG8_BAR; PG8_MMA(0, 0, At, B0); PG8_MMA(0, 1, At, B1); PG8_BAR; PG8_SCHED;
            PG8_LDA(At, 0, 1); PG8_STAGE(PG8_SB(0, 0), b2, voffB); PG8_STAGE(PG8_SB(0, 1), b2 + hstepB, voffB); PG8_STAGE(PG8_SA(0, 0), a2, voffA);
            PG8_WAIT_V(8); PG8_WAIT_L(0); PG8_BAR; PG8_MMA(1, 0, At, B0); PG8_MMA(1, 1, At, B1); PG8_BAR; PG8_SCHED;
            PG8_LDB(B0, 1, 0); PG8_LDB(B1, 1, 1); PG8_SCHED; PG8_LDA(At, 1, 0); PG8_STAGE(PG8_SA(0, 1), a2 + hstepA, voffA);
            PG8_WAIT_V(8); PG8_WAIT_L(0); PG8_BAR; PG8_MMA(0, 0, At, B0); PG8_MMA(0, 1, At, B1); PG8_BAR; PG8_SCHED;
            PG8_LDA(At, 1, 1); PG8_STAGE(PG8_SB(1, 0), b3, voffB); PG8_STAGE(PG8_SB(1, 1), b3 + hstepB, voffB); PG8_STAGE(PG8_SA(1, 0), a3, voffA);
            PG8_WAIT_V(8); PG8_WAIT_L(0); PG8_BAR; PG8_MMA(1, 0, At, B0); PG8_MMA(1, 1, At, B1); PG8_BAR; PG8_SCHED;
        }
        if (wr == 0) PG8_BAR;
        const bool keep = E(acc, cur, wr, wc, fr, fq);
        if (!has_next) break;
        if (!keep) {
#pragma unroll
            for (int a = 0; a < 2; ++a)
#pragma unroll
                for (int b = 0; b < 2; ++b)
#pragma unroll
                    for (int m = 0; m < 4; ++m)
#pragma unroll
                        for (int n = 0; n < 2; ++n) acc[a][b][m][n] = (f32x4){0.f, 0.f, 0.f, 0.f};
        }
        cur = nxt; cA = nA; cB = nB; ++ui;
        if (wr == 1) PG8_BAR;
    }
    PG8_WAIT_V(0);
    PG8_BAR;
#undef PG8_SA
#undef PG8_SB
#undef PG8_STAGE
#undef PG8_LDA
#undef PG8_LDB
#undef PG8_MMA
#undef PG8_WAIT_V
#undef PG8_WAIT_L
#undef PG8_BAR
#undef PG8_SCHED
}

struct SchedTile {
    const char* A; const char* B; size_t tstepA, tstepB; int nM, nN, nwg, G, c;
    __device__ __forceinline__ void init(const void* A_, const void* B_, int lda, int ldb, int M, int N, int G_, int c_) {
        A = (const char*)A_; B = (const char*)B_; tstepA = (size_t)BM * lda * 2; tstepB = (size_t)BM * ldb * 2; nM = M / BM; nN = N / BM; nwg = nM * nN; G = G_; c = c_; }
    __device__ __forceinline__ bool tile(int i, int& pm, int& pn) const {
        const long L = (long)i * G + c; if (L >= nwg) return false;
        int wgid = (int)L; { const int q = nwg / NXCD, r = nwg % NXCD, xcd = wgid % NXCD, off = wgid / NXCD; wgid = (xcd < r ? xcd * (q + 1) : r * (q + 1) + (xcd - r) * q) + off; }
        const int nig = WGM * nN, gid = wgid / nig, fm = gid * WGM, gsz = (nM - fm) < WGM ? (nM - fm) : WGM;
        pm = fm + ((wgid % nig) % gsz); pn = (wgid % nig) / gsz; return true; }
    __device__ __forceinline__ bool next(int i, Unit& u) const {
        int pm, pn; if (!tile(i, pm, pn)) return false;
        u.pm = pm; u.pn = pn; u.g = 0; u.half = 0; u.a = A + (size_t)pm * tstepA; u.b = B + (size_t)pn * tstepB; return true; }
};
struct SchedDual {
    SchedTile t; const char* A2; const char* B2;
    __device__ __forceinline__ bool next(int i, Unit& u) const {
        int pm, pn; if (!t.tile(i >> 1, pm, pn)) return false;
        u.pm = pm; u.pn = pn; u.g = 0; u.half = i & 1;
        u.a = ((i & 1) ? A2 : t.A) + (size_t)pm * t.tstepA; u.b = ((i & 1) ? B2 : t.B) + (size_t)pn * t.tstepB; return true; }
};
struct SchedGrp {
    const char* A; const char* B; size_t gstepA, tstepA, gstepB; int G, c, nunits;
    __device__ __forceinline__ bool next(int i, Unit& u) const {
        const int L = i * G + c; if (L >= nunits) return false;
        u.g = L >> 2; u.pm = L & 3; u.pn = 0; u.half = 0; u.a = A + (size_t)u.g * gstepA + (size_t)u.pm * tstepA; u.b = B + (size_t)u.g * gstepB; return true; }
};
struct SchedMini {
    const char* PWT; const char* WIN16; int G, c;
    __device__ __forceinline__ bool next(int i, Unit& u) const {
        const int L = i * G + c; if (L >= 16) return false;
        u.pm = L >> 2; u.pn = L & 3; u.g = 0; u.half = 0; u.a = PWT + (size_t)u.pm * 256 * 256 * 2; u.b = WIN16 + ((size_t)u.pn * 256 * 1024 + (size_t)u.pm * 256) * 2; return true; }
};

struct EpiPlain {
    bf16_t* O; int ldc;
    __device__ __forceinline__ bool operator()(Acc& acc, const Unit& u, int wr, int wc, int fr, int fq) const {
        const int row0 = u.pm * BM + wr * 64 + fr, col0 = u.pn * BM + wc * 32 + 8 * fq;
#pragma unroll
        for (int ai = 0; ai < 2; ++ai)
#pragma unroll
            for (int m = 0; m < 4; ++m) { bf16_t* rowp = O + (size_t)(row0 + ai * HALF + m * 16) * ldc + col0;
#pragma unroll
                for (int bj = 0; bj < 2; ++bj) *(u32x4*)(rowp + bj * HALF) = pack8(acc[ai][bj][m][0], acc[ai][bj][m][1]); }
        return false;
    }
};
struct EpiIn {
    unsigned char* ws; unsigned char* outb;
    __device__ __forceinline__ bool operator()(Acc& acc, const Unit& u, int wr, int wc, int fr, int fq) const {
        const int sg = u.pn >> 2, mode = (sg == 1 || sg == 3) ? 1 : (sg >= 4 ? 2 : 0);
        const int row0 = u.pm * BM + wr * 64 + fr, col0 = (u.pn & 3) * BM + wc * 32 + 8 * fq;
        const size_t so = (sg == 0) ? ((size_t)80 << 20) : (sg == 1) ? ((size_t)112 << 20) : (sg == 2) ? ((size_t)144 << 20) : (sg == 3) ? ((size_t)192 << 20) : (sg == 4) ? ((size_t)224 << 20) : ((size_t)32 << 20);
        bf16_t* base = (bf16_t*)(((sg == 5) ? outb : ws) + so);
#pragma unroll
        for (int ai = 0; ai < 2; ++ai)
#pragma unroll
            for (int m = 0; m < 4; ++m) { const int row = row0 + ai * HALF + m * 16;
#pragma unroll
                for (int bj = 0; bj < 2; ++bj) { const int col = col0 + bj * HALF; f32x4 v0 = acc[ai][bj][m][0], v1 = acc[ai][bj][m][1];
#pragma unroll
                    for (int j = 0; j < 4; ++j) { const float s0 = sigm(v0[j]), s1 = sigm(v1[j]); v0[j] = mode == 0 ? v0[j] : (mode == 1 ? v0[j] * s0 : s0); v1[j] = mode == 0 ? v1[j] : (mode == 1 ? v1[j] * s1 : s1); }
                    const size_t off = (sg == 2) ? ((size_t)((col >> 4) * 1024 + (row >> 4)) * 384 + (size_t)((row & 15) * 16 + (col & 15))) : ((size_t)row * 1024 + col);
                    *(u32x4*)(base + off) = pack8(v0, v1); } }
        return false;
    }
};
struct EpiS {
    float* SL;
    __device__ __forceinline__ bool operator()(Acc& acc, const Unit& u, int wr, int wc, int fr, int fq) const {
        const int row0 = u.pm * BM + wr * 64 + fr, col0 = wc * 32 + 8 * fq;
#pragma unroll
        for (int ai = 0; ai < 2; ++ai)
#pragma unroll
            for (int m = 0; m < 4; ++m) { float* p = SL + ((size_t)(row0 + ai * HALF + m * 16) * 64 + u.g) * 128 + col0;
                *(f32x4*)p = acc[ai][0][m][0]; *(f32x4*)(p + 4) = acc[ai][0][m][1]; }
        return false;
    }
};
struct EpiY {
    const bf16_t* AS; const float* D; bf16_t* YG;
    __device__ __forceinline__ bool operator()(Acc& acc, const Unit& u, int wr, int wc, int fr, int fq) const {
        const int row0 = u.pm * BM + wr * 64 + fr, col0 = wc * 32 + 8 * fq, h0 = 8 * (fq & 1);
        const f32x4 d0 = *(const f32x4*)(D + u.g * 16 + h0), d1 = *(const f32x4*)(D + u.g * 16 + h0 + 4);
#pragma unroll
        for (int ai = 0; ai < 2; ++ai)
#pragma unroll
            for (int m = 0; m < 4; ++m) { const int cr = row0 + ai * HALF + m * 16;
#pragma unroll
                for (int bj = 0; bj < 2; ++bj) { const int col = col0 + bj * HALF, t = col >> 4;
                    const u32x4 uw = *(const u32x4*)(AS + ((size_t)(u.g * 1024 + cr)) * 384 + col); f32x4 u0, u1; unpack8(uw, u0, u1);
                    f32x4 v0 = acc[ai][bj][m][0] + d0 * u0, v1 = acc[ai][bj][m][1] + d1 * u1;
#pragma unroll
                    for (int j = 0; j < 4; ++j) { const float a = v0[j], b = v1[j];
                        v0[j] = a * sigm(1.5957691216f * (a + 0.044715f * a * a * a)); v1[j] = b * sigm(1.5957691216f * (b + 0.044715f * b * b * b)); }
                    *(u32x4*)(YG + (size_t)(cr * 16 + t) * 1024 + u.g * 16 + h0) = pack8(v0, v1); } }
        return false;
    }
};
struct EpiGlu {
    const bf16_t* YG; bf16_t* ZS; const float* bias;
    __device__ __forceinline__ bool operator()(Acc& acc, const Unit& u, int wr, int wc, int fr, int fq) const {
        const int row0 = u.pm * BM + wr * 64 + fr, col0 = u.pn * BM + wc * 32 + 8 * fq;
        f32x4 bv[2][2];
#pragma unroll
        for (int bj = 0; bj < 2; ++bj) { bv[bj][0] = *(const f32x4*)(bias + col0 + bj * HALF); bv[bj][1] = *(const f32x4*)(bias + col0 + bj * HALF + 4); }
#pragma unroll
        for (int ai = 0; ai < 2; ++ai)
#pragma unroll
            for (int m = 0; m < 4; ++m) { const size_t ro = (size_t)(row0 + ai * HALF + m * 16) * 1024 + col0;
#pragma unroll
                for (int bj = 0; bj < 2; ++bj) { f32x4 y0, y1, z0, z1; unpack8(*(const u32x4*)(YG + ro + bj * HALF), y0, y1); unpack8(*(const u32x4*)(ZS + ro + bj * HALF), z0, z1);
                    f32x4 v0 = acc[ai][bj][m][0] + bv[bj][0], v1 = acc[ai][bj][m][1] + bv[bj][1];
#pragma unroll
                    for (int j = 0; j < 4; ++j) { v0[j] = y0[j] * sigm(v0[j]) * z0[j]; v1[j] = y1[j] * sigm(v1[j]) * z1[j]; }
                    *(u32x4*)(ZS + ro + bj * HALF) = pack8(v0, v1); } }
        return false;
    }
};
struct EpiBr {
    const bf16_t* GP; const bf16_t* GS; bf16_t* MG;
    __device__ __forceinline__ bool operator()(Acc& acc, const Unit& u, int wr, int wc, int fr, int fq) const {
        const int row0 = u.pm * BM + wr * 64 + fr, col0 = u.pn * BM + wc * 32 + 8 * fq;
        const bool first = (u.half == 0);
#pragma unroll
        for (int ai = 0; ai < 2; ++ai)
#pragma unroll
            for (int m = 0; m < 4; ++m) { const size_t ro = (size_t)(row0 + ai * HALF + m * 16) * 1024 + col0;
#pragma unroll
                for (int bj = 0; bj < 2; ++bj) { f32x4 s0, s1; unpack8(*(const u32x4*)(GS + ro + bj * HALF), s0, s1);
                    if (first) { f32x4 p0, p1; unpack8(*(const u32x4*)(GP + ro + bj * HALF), p0, p1);
#pragma unroll
                        for (int j = 0; j < 4; ++j) { acc[ai][bj][m][0][j] *= p0[j] * __builtin_amdgcn_rcpf(s0[j]); acc[ai][bj][m][1][j] *= p1[j] * __builtin_amdgcn_rcpf(s1[j]); }
                    } else { *(u32x4*)(MG + ro + bj * HALF) = pack8(acc[ai][bj][m][0] * s0, acc[ai][bj][m][1] * s1); } } }
        return first;
    }
};
struct EpiOut {
    float* OUT; float* SSQ;
    __device__ __forceinline__ bool operator()(Acc& acc, const Unit& u, int wr, int wc, int fr, int fq) const {
        const int row0 = u.pm * BM + wr * 64 + fr, col0 = u.pn * BM + wc * 32 + 8 * fq;
#pragma unroll
        for (int ai = 0; ai < 2; ++ai)
#pragma unroll
            for (int m = 0; m < 4; ++m) { const int row = row0 + ai * HALF + m * 16; float* p = OUT + (size_t)row * 1024 + col0; float ss = 0.f;
#pragma unroll
                for (int bj = 0; bj < 2; ++bj) { const f32x4 a = acc[ai][bj][m][0], b = acc[ai][bj][m][1];
                    *(f32x4*)(p + bj * HALF) = a; *(f32x4*)(p + bj * HALF + 4) = b;
                    ss += (a[0] * a[0] + a[1] * a[1]) + (a[2] * a[2] + a[3] * a[3]) + (b[0] * b[0] + b[1] * b[1]) + (b[2] * b[2] + b[3] * b[3]); }
                ss += __shfl_xor(ss, 16); ss += __shfl_xor(ss, 32);
                if (fq == 0) SSQ[(size_t)row * 16 + u.pn * 4 + wc] = ss; }
        return false;
    }
};
}

constexpr int NWAVES = 8;
constexpr int BATCH = 2, T = 8192, D = 1024, M = BATCH * T, NIN = 6144;
constexpr int SG = 64, SP = 64, SH = 16, CH = 16, NCR = M / CH  , KY = 384;
constexpr float RMS_EPS = 1e-6f;
typedef unsigned short bf16;
typedef unsigned v4u __attribute__((ext_vector_type(4)));
typedef float f32x4 __attribute__((ext_vector_type(4)));
#define LAS __attribute__((address_space(3)))

constexpr size_t MiB = 1u << 20;
constexpr size_t WS_CTL = 0, CTL_ZERO_BYTES = 64 * 1024;
constexpr size_t WS_MODP = 1 * MiB;
constexpr size_t WS_MODF = WS_MODP + 256 * 1024;
constexpr size_t WS_A16 = WS_MODF + 64 * 1024;
constexpr size_t WS_SSQ = 2 * MiB;
constexpr size_t WS_WIN = 4 * MiB;
constexpr size_t WS_GLU = 16 * MiB, WS_WBP = 18 * MiB, WS_WBS = 20 * MiB, WS_WOUT = 22 * MiB;
constexpr size_t WS_PWT = 24 * MiB;
constexpr size_t WS_WIN16 = 25 * MiB;
constexpr size_t WS_BS = 28 * MiB;
constexpr size_t WS_BY = 36 * MiB;
constexpr size_t WS_H = 48 * MiB;
constexpr size_t WS_V = 80 * MiB;
constexpr size_t WS_ZP = 112 * MiB;
constexpr size_t WS_AS = 144 * MiB;
constexpr size_t WS_ZS = 192 * MiB;
constexpr size_t WS_GP = 224 * MiB;
constexpr size_t WS_END = 256 * MiB;

constexpr int LDS_BYTES = 147456;

struct Args { const float* in[22]; float* out; unsigned char* ws; int ph_lo, ph_hi; };

__device__ __forceinline__ unsigned f2bf(float f) { unsigned u = __builtin_bit_cast(unsigned, f); return (u + 0x7fffu + ((u >> 16) & 1u)) >> 16; }
__device__ __forceinline__ unsigned pk2(float lo, float hi) { return f2bf(lo) | (f2bf(hi) << 16); }
__device__ __forceinline__ float bflo(unsigned w) { return __uint_as_float(w << 16); }
__device__ __forceinline__ float bfhi(unsigned w) { return __uint_as_float(w & 0xffff0000u); }
__device__ __forceinline__ float wave_sum(float v) {
#pragma unroll
    for (int o = 1; o < 64; o <<= 1) v += __shfl_xor(v, o);
    return v;
}


#define XB_TMO      128
#define XB_XCNT(j)  (256  + 64 * (j))
#define XB_XSUB(j)  (1280 + 64 * (j))
#define XB_XGEN(j)  (2304 + 64 * (j))
#define XB_TOP      3328
#define XB_TOPGEN   3392
#define XCD_BAR_WORDS 3456
#define XB_SPIN_CAP (1u << 18)
__device__ __forceinline__ unsigned xb_ld(unsigned* p)              { return __hip_atomic_load(p, __ATOMIC_RELAXED, __HIP_MEMORY_SCOPE_AGENT); }
__device__ __forceinline__ unsigned xb_add(unsigned* p, unsigned v) { return __hip_atomic_fetch_add(p, v, __ATOMIC_RELAXED, __HIP_MEMORY_SCOPE_AGENT); }
__device__ __forceinline__ unsigned xb_xcc_id() { return (unsigned)__builtin_amdgcn_s_getreg((3 << 11) | 20) & 0xFu; }
#define XB_SPIN(cond, bar) do { unsigned _sp = 0; while (cond) { __builtin_amdgcn_s_sleep(1); \
    if ((++_sp & 255u) == 0u) { if (xb_ld(&(bar)[XB_TMO])) break; if (_sp > XB_SPIN_CAP) { atomicAdd(&(bar)[XB_TMO], 1u); break; } } } } while (0)
struct XcdBarrier { unsigned* bar; unsigned x; volatile LAS unsigned* st; };
__device__ __forceinline__ XcdBarrier xcd_barrier_post(unsigned* bar, volatile LAS unsigned* st) {
    XcdBarrier b; b.bar = bar; b.x = xb_xcc_id(); b.st = st;
    if (threadIdx.x == 0) (void)xb_add(&bar[XB_XCNT(b.x)], 1u);
    return b;
}
__device__ __forceinline__ void xcd_barrier_complete(unsigned* bar, unsigned x, unsigned& nloc, unsigned& nx) {
    const unsigned G = gridDim.x * gridDim.y * gridDim.z;
    unsigned sum, cnt, mine, sp = 0u;
    for (;;) {
        sum = 0u; cnt = 0u; mine = 0u;
#pragma unroll
        for (unsigned j = 0; j < 16; ++j) { const unsigned c = xb_ld(&bar[XB_XCNT(j)]); sum += c; cnt += (c > 0u) ? 1u : 0u; mine = (j == x) ? c : mine; }
        if (sum == G) break;
        __builtin_amdgcn_s_sleep(1);
        if ((++sp & 255u) == 0u) { if (xb_ld(&bar[XB_TMO])) break; if (sp > XB_SPIN_CAP) { atomicAdd(&bar[XB_TMO], 1u); break; } }
    }
    nloc = mine > 0u ? mine : 1u; nx = cnt > 0u ? cnt : 1u;
}
__device__ __forceinline__ void xcd_barrier(const XcdBarrier& b) {
    asm volatile("s_waitcnt vmcnt(0)" ::: "memory");
    __syncthreads();
    if (threadIdx.x == 0) {
        unsigned* bar = b.bar;
        __builtin_amdgcn_s_waitcnt(0);
        unsigned nloc = b.st[0], nx = b.st[1];
        if (nloc == 0u) { xcd_barrier_complete(bar, b.x, nloc, nx); b.st[0] = nloc; b.st[1] = nx; }
        const unsigned old = xb_add(&bar[XB_XSUB(b.x)], 1u);
        const unsigned gen = old / nloc;
        if (old + 1u == (gen + 1u) * nloc) {
            __builtin_amdgcn_fence(__ATOMIC_RELEASE, "agent");
            asm volatile("s_waitcnt vmcnt(0)" ::: "memory");
            const unsigned og = xb_add(&bar[XB_TOP], 1u);
            const unsigned tg = og / nx;
            if (og + 1u == (tg + 1u) * nx) xb_add(&bar[XB_TOPGEN], 1u);
            else XB_SPIN(xb_ld(&bar[XB_TOPGEN]) == tg, bar);
            __builtin_amdgcn_fence(__ATOMIC_ACQUIRE, "agent");
            xb_add(&bar[XB_XGEN(b.x)], 1u);
            asm volatile("s_waitcnt vmcnt(0)" ::: "memory");
        } else {
            XB_SPIN(xb_ld(&bar[XB_XGEN(b.x)]) == gen, bar);
            __builtin_amdgcn_fence(__ATOMIC_ACQUIRE, "agent");
            asm volatile("s_waitcnt vmcnt(0)" ::: "memory");
        }
    }
    __syncthreads();
}

__device__ __forceinline__ void p0_transpose_item(const float* W, int ldw, int nblk, bf16* WT, int ldt, int row_off, LAS float* scr, int item, int lane) {
    const int kb = item / nblk, nb = item % nblk, k0 = 64 * kb, n0 = 32 * nb;
#pragma unroll 8
    for (int i = 0; i < 32; ++i) { const int kk = 2 * i + (lane >> 5); scr[kk * 33 + (lane & 31)] = W[(size_t)(k0 + kk) * ldw + n0 + (lane & 31)]; }
    asm volatile("s_waitcnt lgkmcnt(0)" ::: "memory");
    const int c = lane & 7;
#pragma unroll
    for (int j = 0; j < 4; ++j) { const int n = (lane >> 3) + 8 * j; const LAS float* s = scr + (8 * c) * 33 + n;
        v4u o; o.x = pk2(s[0 * 33], s[1 * 33]); o.y = pk2(s[2 * 33], s[3 * 33]); o.z = pk2(s[4 * 33], s[5 * 33]); o.w = pk2(s[6 * 33], s[7 * 33]);
        *(v4u*)(WT + (size_t)(row_off + n0 + n) * ldt + k0 + 8 * c) = o; }
    asm volatile("s_waitcnt lgkmcnt(0)" ::: "memory");
}

__device__ __forceinline__ void ssm_setup(const Args& args, int g, LAS float* L, int tid) {
    LAS float* pwr = L;
    LAS float* pwi = L + 17 * 64;
    LAS float* bbr = L + 34 * 64;
    LAS float* bbi = bbr + 1024;
    LAS float* cre = bbi + 1024;
    LAS float* cim = cre + 1024;
    LAS float* KT = cim + 1024;
    const float* a_re = args.in[9]; const float* a_im = args.in[10]; const float* log_dt = args.in[11];
    const float* b_re = args.in[12]; const float* b_im = args.in[13]; const float* c_re = args.in[14]; const float* c_im = args.in[15];
    unsigned char* ws = args.ws;
    if (tid < 64) {
        const int p = tid;
        const float dt = expf(log_dt[g]);
        const float lr = fminf(a_re[g * 64 + p], -1e-4f), li = a_im[g * 64 + p];
        const float xr = lr * dt;
        const double thd = (double)li * (double)dt;
#pragma unroll 1
        for (int j = 0; j <= 16; ++j) {
            const double tj = thd * (double)j; const double kk = rint(tj * 0.15915494309189535); const float r = (float)(tj - kk * 6.283185307179586);
            const float mg = expf(xr * (float)j);
            pwr[j * 64 + p] = mg * cosf(r); pwi[j * 64 + p] = mg * sinf(r);
        }
        const double k1 = rint(thd * 0.15915494309189535); const float r1 = (float)(thd - k1 * 6.283185307179586);
        const float c1 = cosf(r1), s1 = sinf(r1), sh = sinf(0.5f * r1), mg1 = expf(xr);
        const float num_re = expm1f(xr) * c1 - 2.f * sh * sh, num_im = mg1 * s1;
        const float den = lr * lr + li * li;
        const float f_re = (num_re * lr + num_im * li) / den, f_im = (num_im * lr - num_re * li) / den;
#pragma unroll 4
        for (int h = 0; h < 16; ++h) { const float br = b_re[(g * 64 + p) * 16 + h], bi = b_im[(g * 64 + p) * 16 + h];
            bbr[p * 16 + h] = f_re * br - f_im * bi; bbi[p * 16 + h] = f_re * bi + f_im * br; }
    }
    for (int i = tid; i < 1024; i += 512) { cre[i] = c_re[g * 1024 + i]; cim[i] = c_im[g * 1024 + i]; }
    __syncthreads();
    if (tid < 64) { float* a16 = (float*)(ws + WS_A16); a16[(g * 64 + tid) * 2] = pwr[16 * 64 + tid]; a16[(g * 64 + tid) * 2 + 1] = pwi[16 * 64 + tid]; }
    {
        const int j = tid >> 5, h = (tid >> 1) & 15, hb = (tid & 1) * 8;
        float kacc[8];
#pragma unroll
        for (int i = 0; i < 8; ++i) kacc[i] = 0.f;
#pragma unroll 4
        for (int p = 0; p < 64; ++p) { const float cr = cre[h * 64 + p], ci = cim[h * 64 + p], pr = pwr[j * 64 + p], pi = pwi[j * 64 + p];
            const float ar = cr * pr - ci * pi, ai = cr * pi + ci * pr;
#pragma unroll
            for (int i = 0; i < 8; ++i) kacc[i] += ar * bbr[p * 16 + hb + i] - ai * bbi[p * 16 + hb + i]; }
#pragma unroll
        for (int i = 0; i < 8; ++i) KT[(j * 16 + h) * 16 + hb + i] = kacc[i];
    }
    __syncthreads();
    bf16* BY = (bf16*)(ws + WS_BY) + (size_t)g * 256 * KY;
    for (int v = tid; v < 256 * 48; v += 512) {
        const int n = v / 48, k0 = (v % 48) * 8, t = n >> 4, h = n & 15; float val[8];
        if (k0 < 256) { const int tp = k0 >> 4, hh0 = k0 & 15;
#pragma unroll
            for (int i = 0; i < 8; ++i) val[i] = (tp <= t) ? KT[((t - tp) * 16 + h) * 16 + hh0 + i] : 0.f;
        } else if (k0 < 320) { const int p0 = k0 - 256;
#pragma unroll
            for (int i = 0; i < 8; ++i) val[i] = cre[h * 64 + p0 + i] * pwr[(t + 1) * 64 + p0 + i] - cim[h * 64 + p0 + i] * pwi[(t + 1) * 64 + p0 + i];
        } else { const int p0 = k0 - 320;
#pragma unroll
            for (int i = 0; i < 8; ++i) val[i] = -(cre[h * 64 + p0 + i] * pwi[(t + 1) * 64 + p0 + i] + cim[h * 64 + p0 + i] * pwr[(t + 1) * 64 + p0 + i]);
        }
        v4u o; o.x = pk2(val[0], val[1]); o.y = pk2(val[2], val[3]); o.z = pk2(val[4], val[5]); o.w = pk2(val[6], val[7]);
        *(v4u*)(BY + (size_t)n * KY + k0) = o;
    }
    bf16* BS = (bf16*)(ws + WS_BS) + (size_t)g * 256 * 256;
    for (int v = tid; v < 256 * 32; v += 512) {
        const int n = v >> 5, k0 = (v & 31) * 8, t = k0 >> 4, hh0 = k0 & 15; float val[8];
        if (n < 128) { const int p = n & 63; const float pr = pwr[(15 - t) * 64 + p], pi = pwi[(15 - t) * 64 + p];
#pragma unroll
            for (int i = 0; i < 8; ++i) { const float br = bbr[p * 16 + hh0 + i], bi = bbi[p * 16 + hh0 + i]; val[i] = (n < 64) ? (pr * br - pi * bi) : (pr * bi + pi * br); }
        } else {
#pragma unroll
            for (int i = 0; i < 8; ++i) val[i] = 0.f;
        }
        v4u o; o.x = pk2(val[0], val[1]); o.y = pk2(val[2], val[3]); o.z = pk2(val[4], val[5]); o.w = pk2(val[6], val[7]);
        *(v4u*)(BS + (size_t)n * 256 + k0) = o;
    }
    __syncthreads();
}

__global__ void __launch_bounds__(NWAVES * 64, 2) fwd_megakernel(Args args) {
    extern __shared__ __attribute__((aligned(16))) unsigned char lds_raw[];
    LAS unsigned char* lds = (LAS unsigned char*)lds_raw;
    const int tid = threadIdx.x, lane = tid & 63, wave = __builtin_amdgcn_readfirstlane(tid >> 6);
    const int G = gridDim.x, bx = blockIdx.x;
    const int gw = bx * NWAVES + wave, NGW = G * NWAVES;
    unsigned char* ws = args.ws;
#if MK_SPLIT
    const int lo = args.ph_lo, hi = args.ph_hi;
#else
    constexpr int lo = 0, hi = 10;
#endif
#ifndef MK_PHASES
#define MK_PHASES 0x3ff
#endif
#define IN(k) (((MK_PHASES >> (k)) & 1) && lo <= (k) && (k) < hi)
#if MK_USE_CG
#define GRID_BAR(k) do { if (IN(k) && IN((k) + 1)) { cg::this_grid().sync(); } } while (0)
#else
#define GRID_BAR(k) do { if (IN(k) && IN((k) + 1)) { xcd_barrier(xbar); } } while (0)
    if (tid < 2) ((volatile LAS unsigned*)(lds + 131072 + 1024))[tid] = 0u;
    __syncthreads();
    const XcdBarrier xbar = xcd_barrier_post((unsigned*)(ws + WS_CTL), (volatile LAS unsigned*)(lds + 131072 + 1024));
    if (args.ph_hi == 12345) cg::this_grid().sync();
#endif

    const float* x = args.in[0];
    bf16* WIN = (bf16*)(ws + WS_WIN); bf16* GLUT = (bf16*)(ws + WS_GLU); bf16* WBP = (bf16*)(ws + WS_WBP); bf16* WBS = (bf16*)(ws + WS_WBS); bf16* WOUT = (bf16*)(ws + WS_WOUT);
    bf16* PWT = (bf16*)(ws + WS_PWT); bf16* WIN16 = (bf16*)(ws + WS_WIN16);
    bf16* Hb = (bf16*)(ws + WS_H); bf16* Vb = (bf16*)(ws + WS_V); bf16* ZP = (bf16*)(ws + WS_ZP); bf16* AS = (bf16*)(ws + WS_AS); bf16* ZS = (bf16*)(ws + WS_ZS); bf16* GP = (bf16*)(ws + WS_GP);
    bf16* GS = (bf16*)((unsigned char*)args.out + 32 * MiB); float* SL = (float*)args.out;
    bf16* YP = Hb; bf16* YG = Vb; bf16* MG = ZP;
    float* MODP = (float*)(ws + WS_MODP); float* MODF = (float*)(ws + WS_MODF); float* A16 = (float*)(ws + WS_A16); float* SSQ = (float*)(ws + WS_SSQ);

    if (IN(0)) {
        if (bx < SG) ssm_setup(args, bx, (LAS float*)lds, tid);
        LAS float* scr = (LAS float*)(lds + wave * 16384);
        constexpr int I_IN = 16 * 160, I_SQ = 16 * 32, I_PW = 4 * 8;
        constexpr int NT = I_IN + 4 * I_SQ + 4 * I_PW, NCV = 1024, NGV = 48 * 8;
        for (int it = gw; it < NT + NCV + NGV; it += NGW) {
            int r = it;
            if (r < I_IN) { p0_transpose_item(args.in[6] + 1024, NIN, 160, WIN, 1024, 1024, scr, r, lane); continue; } r -= I_IN;
            if (r < I_SQ) { p0_transpose_item(args.in[17], 1024, 32, GLUT, 1024, 0, scr, r, lane); continue; } r -= I_SQ;
            if (r < I_SQ) { p0_transpose_item(args.in[19], 1024, 32, WBP, 1024, 0, scr, r, lane); continue; } r -= I_SQ;
            if (r < I_SQ) { p0_transpose_item(args.in[20], 1024, 32, WBS, 1024, 0, scr, r, lane); continue; } r -= I_SQ;
            if (r < I_SQ) { p0_transpose_item(args.in[21], 1024, 32, WOUT, 1024, 0, scr, r, lane); continue; } r -= I_SQ;
            if (r < 4 * I_PW) { const int pg = r / I_PW; p0_transpose_item(args.in[7] + (size_t)pg * 65536, 256, 8, PWT, 256, pg * 256, scr, r % I_PW, lane); continue; } r -= 4 * I_PW;
            if (r < NCV) {
                const float* src = args.in[6] + (size_t)r * NIN; bf16* dst = WIN16 + (size_t)r * 1024;
#pragma unroll
                for (int j = 0; j < 4; ++j) { const f32x4 v = *(const f32x4*)(src + 4 * lane + 256 * j);
                    *(unsigned long long*)(dst + 4 * lane + 256 * j) = (unsigned long long)pk2(v.x, v.y) | ((unsigned long long)pk2(v.z, v.w) << 32); }
                continue; } r -= NCV;
            {
                const int jb = r >> 3, ks = r & 7, j = jb * 64 + lane; const float* cc = args.in[1]; const float* wa = args.in[2];
                float p0 = 0.f, p1 = 0.f;
#pragma unroll 8
                for (int k = ks * 128; k < ks * 128 + 128; ++k) { const float c0 = cc[k], c1 = cc[1024 + k]; const float a0 = c0 * pg8::sigm(c0), a1 = c1 * pg8::sigm(c1);
                    const float w = wa[(size_t)k * 3072 + j]; p0 += a0 * w; p1 += a1 * w; }
                MODP[(ks * 2 + 0) * 3072 + j] = p0; MODP[(ks * 2 + 1) * 3072 + j] = p1;
            }
        }
    }
    GRID_BAR(0);

    if (IN(1)) {
        if (bx < 16) {
            pg8::SchedMini S{(const char*)PWT, (const char*)WIN16, G, bx}; pg8::EpiPlain E{WIN, 1024};
            pg8::gemm_phase<pg8::EpiPlain, pg8::SchedMini, 256, 1024, 256>(lds, S, E);
        }
        __syncthreads();
        LAS float* modl = (LAS float*)lds;
        for (int i = tid; i < 6144; i += 512) { const int j = i % 3072, b = i / 3072; float s = args.in[3][j];
#pragma unroll
            for (int ks = 0; ks < 8; ++ks) s += MODP[(ks * 2 + b) * 3072 + j];
            modl[i] = s; if (bx == 0) MODF[i] = s; }
        __syncthreads();
        const float* gain = args.in[4];
        for (int m = gw; m < M; m += NGW) {
            const int b = m >> 13; const float* xr = x + (size_t)m * D; f32x4 v[4]; float s = 0.f;
#pragma unroll
            for (int j = 0; j < 4; ++j) { v[j] = *(const f32x4*)(xr + 4 * lane + 256 * j); s += (v[j].x * v[j].x + v[j].y * v[j].y) + (v[j].z * v[j].z + v[j].w * v[j].w); }
            const float rstd = rsqrtf(wave_sum(s) * (1.f / D) + RMS_EPS);
#pragma unroll
            for (int j = 0; j < 4; ++j) { const int col = 4 * lane + 256 * j; const f32x4 gn = *(const f32x4*)(gain + col);
                const f32x4 sh = *(const LAS f32x4*)(modl + b * 3072 + col), sc = *(const LAS f32x4*)(modl + b * 3072 + 1024 + col);
                const f32x4 h = v[j] * rstd * gn * (sc + 1.f) + sh;
                *(unsigned long long*)(Hb + (size_t)m * D + col) = (unsigned long long)pk2(h.x, h.y) | ((unsigned long long)pk2(h.z, h.w) << 32); }
        }
        __syncthreads();
    }
    GRID_BAR(1);

    if (IN(2)) {
        pg8::SchedTile S; S.init(Hb, WIN, 1024, 1024, M, NIN, G, bx);
        pg8::EpiIn E{ws, (unsigned char*)args.out};
        static_assert(WS_V == (80u << 20) && WS_ZP == (112u << 20) && WS_AS == (144u << 20) && WS_ZS == (192u << 20) && WS_GP == (224u << 20), "EpiIn segment map");
        pg8::gemm_phase<pg8::EpiIn, pg8::SchedTile, 1024, 1024, 1024>(lds, S, E);
    }
    GRID_BAR(2);

    if (IN(3)) {
        pg8::SchedGrp S{(const char*)AS, (const char*)(ws + WS_BS), (size_t)NCR * KY * 2, (size_t)256 * KY * 2, (size_t)256 * 256 * 2, G, bx, 256};
        pg8::EpiS E{SL};
        pg8::gemm_phase<pg8::EpiS, pg8::SchedGrp, KY, 256, 256>(lds, S, E);
    }
    GRID_BAR(3);

    if (IN(4)) {
        for (int task = bx; task < 128; task += G) {
            if (wave == 0) {
                const int b = task >> 6, g = task & 63, p = lane;
                const float ar = A16[(g * 64 + p) * 2], ai = A16[(g * 64 + p) * 2 + 1];
                float sr = 0.f, si = 0.f;
                const float* sl = SL + ((size_t)(b * 512) * 64 + g) * 128 + p;
                bf16* as = AS + ((size_t)(g * 1024 + b * 512)) * KY + 256 + p;
#pragma unroll 8
                for (int c = 0; c < 512; ++c) {
                    const float lr = sl[(size_t)c * 64 * 128], li = sl[(size_t)c * 64 * 128 + 64];
                    as[(size_t)c * KY] = (bf16)f2bf(sr); as[(size_t)c * KY + 64] = (bf16)f2bf(si);
                    const float nr = ar * sr - ai * si + lr, ni = ar * si + ai * sr + li; sr = nr; si = ni;
                }
            }
        }
        const float* pscale = args.in[8];
        for (int task = ((gw + NGW - 128 * NWAVES) % NGW); task < 1024; task += NGW) {
            const int seg = task >> 1, hf = task & 1, ch0 = hf * 512 + lane * 8, gi = ch0 >> 8, w = 2 << gi;
            const int m0 = seg * 32, tb = m0 & (T - 1);
            float s[8];
#pragma unroll
            for (int i = 0; i < 8; ++i) s[i] = 0.f;
            for (int d = 1; d <= 16; ++d) if (d <= w && tb - d >= 0) { const v4u q = *(const v4u*)(Vb + (size_t)(m0 - d) * D + ch0);
                s[0] += bflo(q.x); s[1] += bfhi(q.x); s[2] += bflo(q.y); s[3] += bfhi(q.y); s[4] += bflo(q.z); s[5] += bfhi(q.z); s[6] += bflo(q.w); s[7] += bfhi(q.w); }
            const f32x4 ps0 = *(const f32x4*)(pscale + ch0), ps1 = *(const f32x4*)(pscale + ch0 + 4);
            const float psc[8] = {ps0.x, ps0.y, ps0.z, ps0.w, ps1.x, ps1.y, ps1.z, ps1.w};
#pragma unroll 4
            for (int i = 0; i < 32; ++i) {
                const int m = m0 + i, t = tb + i;
                const v4u q = *(const v4u*)(Vb + (size_t)m * D + ch0); const v4u z = *(const v4u*)(ZP + (size_t)m * D + ch0);
                float v[8] = {bflo(q.x), bfhi(q.x), bflo(q.y), bfhi(q.y), bflo(q.z), bfhi(q.z), bflo(q.w), bfhi(q.w)};
                const float zz[8] = {bflo(z.x), bfhi(z.x), bflo(z.y), bfhi(z.y), bflo(z.z), bfhi(z.z), bflo(z.w), bfhi(z.w)};
#pragma unroll
                for (int k = 0; k < 8; ++k) s[k] += v[k];
                if (t >= w) { const v4u o = *(const v4u*)(Vb + (size_t)(m - w) * D + ch0);
                    s[0] -= bflo(o.x); s[1] -= bfhi(o.x); s[2] -= bflo(o.y); s[3] -= bfhi(o.y); s[4] -= bflo(o.z); s[5] -= bfhi(o.z); s[6] -= bflo(o.w); s[7] -= bfhi(o.w); }
                const float inv = 1.f / (float)((t + 1 < w) ? (t + 1) : w);
                float r[8];
#pragma unroll
                for (int k = 0; k < 8; ++k) r[k] = (s[k] * inv - v[k]) * psc[k] * zz[k];
                v4u o; o.x = pk2(r[0], r[1]); o.y = pk2(r[2], r[3]); o.z = pk2(r[4], r[5]); o.w = pk2(r[6], r[7]);
                *(v4u*)(YP + (size_t)m * D + ch0) = o;
            }
        }
    }
    GRID_BAR(4);

    if (IN(5)) {
        pg8::SchedGrp S{(const char*)AS, (const char*)(ws + WS_BY), (size_t)NCR * KY * 2, (size_t)256 * KY * 2, (size_t)256 * KY * 2, G, bx, 256};
        pg8::EpiY E{AS, args.in[16], YG};
        pg8::gemm_phase<pg8::EpiY, pg8::SchedGrp, KY, KY, KY>(lds, S, E);
    }
    GRID_BAR(5);

    if (IN(6)) {
        pg8::SchedTile S; S.init(YG, GLUT, 1024, 1024, M, D, G, bx);
        pg8::EpiGlu E{YG, ZS, args.in[18]};
        pg8::gemm_phase<pg8::EpiGlu, pg8::SchedTile, 1024, 1024, 1024>(lds, S, E);
    }
    GRID_BAR(6);

    if (IN(7)) {
        pg8::SchedDual S; S.t.init(YP, WBP, 1024, 1024, M, D, G, bx); S.A2 = (const char*)ZS; S.B2 = (const char*)WBS;
        pg8::EpiBr E{GP, GS, MG};
        pg8::gemm_phase<pg8::EpiBr, pg8::SchedDual, 1024, 1024, 1024>(lds, S, E);
    }
    GRID_BAR(7);

    if (IN(8)) {
        pg8::SchedTile S; S.init(MG, WOUT, 1024, 1024, M, D, G, bx);
        pg8::EpiOut E{args.out, SSQ};
        pg8::gemm_phase<pg8::EpiOut, pg8::SchedTile, 1024, 1024, 1024>(lds, S, E);
    }
    GRID_BAR(8);

    if (IN(9)) {
        const float* npost = args.in[5];
        for (int m = gw; m < M; m += NGW) {
            const int b = m >> 13;
            float ss = (lane < 16) ? SSQ[(size_t)m * 16 + lane] : 0.f;
            ss = wave_sum(ss);
            const float rstd = rsqrtf(ss * (1.f / D) + RMS_EPS);
            const float* xr = x + (size_t)m * D; float* orow = args.out + (size_t)m * D;
#pragma unroll
            for (int j = 0; j < 4; ++j) { const int col = 4 * lane + 256 * j;
                const f32x4 xv = *(const f32x4*)(xr + col), ov = *(const f32x4*)(orow + col), gn = *(const f32x4*)(npost + col), gt = *(const f32x4*)(MODF + b * 3072 + 2048 + col);
                *(f32x4*)(orow + col) = xv + gt * (ov * rstd * gn); }
        }
    }
#undef IN
#undef GRID_BAR
}

extern "C" void kernel_launch(void* const* d_in, const int* in_sizes, int n_in, void* d_out, int out_size, void* d_ws, size_t ws_size, hipStream_t stream) {
    static int grid = 0;
    if (grid == 0) {
        if (n_in != 22 || in_sizes[0] != M * D || out_size != M * D || ws_size < WS_END) { fprintf(stderr, "kernel_launch: unexpected shapes (n_in %d, in0 %d, out %d, ws %zu); nothing launched\n", n_in, n_in > 0 ? in_sizes[0] : -1, out_size, ws_size); grid = -1; return; }
        int dev = 0, cus = 0, per_cu = 0;
        if (hipGetDevice(&dev) != hipSuccess || hipDeviceGetAttribute(&cus, hipDeviceAttributeMultiprocessorCount, dev) != hipSuccess) { grid = -1; return; }
        if (hipFuncSetAttribute((const void*)fwd_megakernel, hipFuncAttributeMaxDynamicSharedMemorySize, LDS_BYTES) != hipSuccess) { fprintf(stderr, "kernel_launch: hipFuncSetAttribute failed\n"); grid = -1; return; }
        if (hipOccupancyMaxActiveBlocksPerMultiprocessor(&per_cu, (const void*)fwd_megakernel, NWAVES * 64, LDS_BYTES) != hipSuccess || per_cu < 1) { fprintf(stderr, "kernel_launch: occupancy query says %d\n", per_cu); per_cu = 1; }
        (void)hipGetLastError();
        grid = cus;
    }
    if (grid < 0) return;
#if !MK_USE_CG
    if (hipMemsetAsync((char*)d_ws + WS_CTL, 0, CTL_ZERO_BYTES, stream) != hipSuccess) { fprintf(stderr, "kernel_launch: memset of the barrier words failed\n"); return; }
#endif
    Args a{};
    for (int i = 0; i < 22; ++i) a.in[i] = (const float*)d_in[i];
    a.out = (float*)d_out; a.ws = (unsigned char*)d_ws;
#if MK_SPLIT
    for (int ph = 0; ph < 10; ++ph) {
        a.ph_lo = ph; a.ph_hi = ph + 1; void* kargs[] = {&a};
        hipError_t e = hipLaunchCooperativeKernel((const void*)fwd_megakernel, dim3(grid), dim3(NWAVES * 64), kargs, LDS_BYTES, stream);
        if (e != hipSuccess) { fprintf(stderr, "kernel_launch: cooperative launch (phase %d) failed: %s\n", ph, hipGetErrorString(e)); break; }
    }
#else
    a.ph_lo = 0; a.ph_hi = 10; void* kargs[] = {&a};
    hipError_t e = hipLaunchCooperativeKernel((const void*)fwd_megakernel, dim3(grid), dim3(NWAVES * 64), kargs, LDS_BYTES, stream);
    if (e != hipSuccess) fprintf(stderr, "kernel_launch: cooperative launch failed: %s (grid %d)\n", hipGetErrorString(e), grid);
#endif
}
```

```cpp
#include <hip/hip_runtime.h>
#include <hip/hip_cooperative_groups.h>
#include <cstdio>
#include <cstdint>
namespace cg = cooperative_groups;

#ifndef MK_USE_CG
#define MK_USE_CG 0
#endif
#ifndef MK_REPEAT
#define MK_REPEAT 0
#endif
#ifndef MK_SPLIT
#define MK_SPLIT 0
#endif

namespace pg8 {
#define PG8_LAS __attribute__((address_space(3)))
typedef unsigned short bf16_t;
typedef short bf16x8 __attribute__((ext_vector_type(8)));
typedef float f32x4 __attribute__((ext_vector_type(4)));
typedef unsigned u32x4 __attribute__((ext_vector_type(4)));
constexpr int BM = 256, BK = 64, HALF = 128, HTB = HALF * BK * 2, STAGE_BYTES = 8 * HTB, NXCD = 8, WGM = 8;

__host__ __device__ __forceinline__ int lds_byte(int r, int c) { const int st = (r >> 4) * 2 + (c >> 5), rr = r & 15, cc = c & 31, ob = rr * 64 + cc * 2; return st * 1024 + (ob ^ (((ob >> 9) & 1) << 5)); }
__host__ __device__ __forceinline__ void stage_rc(int b, int& R, int& C) { const int st = b / 1024, sb = b % 1024, swz = sb ^ (((sb >> 9) & 1) << 5); R = (st >> 1) * 16 + swz / 64; C = (st & 1) * 32 + (swz % 64) / 2; }
__host__ __device__ __forceinline__ int perm32(int rho) { const int n = rho >> 4, i = rho & 15; return 8 * (i >> 2) + 4 * n + (i & 3); }

struct Unit { const char* a; const char* b; int pm, pn, g, half; };

__device__ __forceinline__ unsigned cvt_pk_bf16(float lo, float hi) { unsigned r; asm volatile("v_cvt_pk_bf16_f32 %0, %1, %2" : "=v"(r) : "v"(lo), "v"(hi)); return r; }
__device__ __forceinline__ u32x4 pack8(f32x4 v0, f32x4 v1) { u32x4 w; w.x = cvt_pk_bf16(v0[0], v0[1]); w.y = cvt_pk_bf16(v0[2], v0[3]); w.z = cvt_pk_bf16(v1[0], v1[1]); w.w = cvt_pk_bf16(v1[2], v1[3]); return w; }
__device__ __forceinline__ void unpack8(u32x4 w, f32x4& v0, f32x4& v1) {
    v0[0] = __uint_as_float(w.x << 16); v0[1] = __uint_as_float(w.x & 0xffff0000u); v0[2] = __uint_as_float(w.y << 16); v0[3] = __uint_as_float(w.y & 0xffff0000u);
    v1[0] = __uint_as_float(w.z << 16); v1[1] = __uint_as_float(w.z & 0xffff0000u); v1[2] = __uint_as_float(w.w << 16); v1[3] = __uint_as_float(w.w & 0xffff0000u); }
__device__ __forceinline__ float sigm(float x) { return __builtin_amdgcn_rcpf(1.f + __expf(-x)); }

typedef f32x4 Acc[2][2][4][2];

template <class Epi, class Sched, int LDA, int LDB, int KK>
__device__ __forceinline__ void gemm_phase(PG8_LAS unsigned char* lds, const Sched& S, const Epi& E) {
    int tid_ = threadIdx.x; asm volatile("" : "+v"(tid_));
    const int tid = tid_, wid = __builtin_amdgcn_readfirstlane(tid >> 6), lane = tid & 63, wr = wid >> 2, wc = wid & 3, fr = lane & 15, fq = lane >> 4;
    constexpr int nt = KK / BK;
    unsigned voffA[2], voffB[2];
#pragma unroll
    for (int i = 0; i < 2; ++i) { int R, C; stage_rc(tid * 16 + i * 8192, R, C); const int Rb = (R & ~31) + perm32(R & 31);
        voffA[i] = (unsigned)(R * LDA + C) * 2u; voffB[i] = (unsigned)(Rb * LDB + C) * 2u; }
    constexpr size_t kstep = (size_t)(BK * 2);
    constexpr size_t hstepA = (size_t)HALF * LDA * 2, hstepB = (size_t)HALF * LDB * 2;
    const unsigned ldsw = (unsigned)wid * 1024u;
    const int aoff = lds_byte(wr * 64 + fr, fq * 8), boff = lds_byte(wc * 32 + fr, fq * 8);
#define PG8_SA(b, h) (((b) * 2 + (h)) * HTB)
#define PG8_SB(b, h) ((4 + (b) * 2 + (h)) * HTB)
#define PG8_STAGE(bufoff, gbase, voff) do { _Pragma("unroll") for (int _i = 0; _i < 2; ++_i) \
        __builtin_amdgcn_global_load_lds((const unsigned*)((const char*)(gbase) + (voff)[_i]), (PG8_LAS unsigned*)(lds + (bufoff) + ldsw + _i * 8192), 16, 0, 0); } while (0)
#define PG8_LDA(dst, b, h) do { _Pragma("unroll") for (int m = 0; m < 4; ++m) _Pragma("unroll") for (int k = 0; k < 2; ++k) dst[m][k] = *(const PG8_LAS bf16x8*)(lds + PG8_SA(b, h) + aoff + m * 2048 + k * 1024); } while (0)
#define PG8_LDB(dst, b, h) do { _Pragma("unroll") for (int n = 0; n < 2; ++n) _Pragma("unroll") for (int k = 0; k < 2; ++k) dst[n][k] = *(const PG8_LAS bf16x8*)(lds + PG8_SB(b, h) + boff + n * 2048 + k * 1024); } while (0)
#define PG8_MMA(ai, bj, At, Bt) do { __builtin_amdgcn_s_setprio(1); _Pragma("unroll") for (int m = 0; m < 4; ++m) _Pragma("unroll") for (int n = 0; n < 2; ++n) _Pragma("unroll") for (int k = 0; k < 2; ++k) \
        acc[ai][bj][m][n] = __builtin_amdgcn_mfma_f32_16x16x32_bf16(Bt[n][k], At[m][k], acc[ai][bj][m][n], 0, 0, 0); __builtin_amdgcn_s_setprio(0); } while (0)
#define PG8_WAIT_V(n) asm volatile("s_waitcnt vmcnt(" #n ")" ::: "memory")
#define PG8_WAIT_L(n) asm volatile("s_waitcnt lgkmcnt(" #n ")" ::: "memory")
#define PG8_BAR __builtin_amdgcn_s_barrier()
#define PG8_SCHED __builtin_amdgcn_sched_barrier(0)
    Unit cur, nxt; int ui = 0;
    if (!S.next(0, cur)) return;
    Acc acc;
#pragma unroll
    for (int a = 0; a < 2; ++a)
#pragma unroll
        for (int b = 0; b < 2; ++b)
#pragma unroll
            for (int m = 0; m < 4; ++m)
#pragma unroll
                for (int n = 0; n < 2; ++n) acc[a][b][m][n] = (f32x4){0.f, 0.f, 0.f, 0.f};
    bf16x8 At[4][2], B0[2][2], B1[2][2];
    const char* cA = cur.a; const char* cB = cur.b;
    PG8_STAGE(PG8_SB(0, 0), cB, voffB); PG8_STAGE(PG8_SB(0, 1), cB + hstepB, voffB); PG8_STAGE(PG8_SA(0, 0), cA, voffA); PG8_STAGE(PG8_SA(0, 1), cA + hstepA, voffA);
    if (wr == 1) PG8_BAR;
    PG8_WAIT_V(2); PG8_BAR;
    PG8_STAGE(PG8_SB(1, 0), cB + kstep, voffB); PG8_STAGE(PG8_SA(1, 0), cA + kstep, voffA); PG8_STAGE(PG8_SB(1, 1), cB + hstepB + kstep, voffB);
    PG8_WAIT_V(6); PG8_BAR;
    for (;;) {
        const bool has_next = S.next(ui + 1, nxt);
        const char* nA = has_next ? nxt.a : cA; const char* nB = has_next ? nxt.b : cB;
#pragma nounroll
        for (int t = 0; t < nt; t += 2) {
            const bool last = (t == nt - 2);
            const char* a1 = cA + (size_t)(t + 1) * kstep;
            const char* a2 = last ? nA : cA + (size_t)(t + 2) * kstep; const char* b2 = last ? nB : cB + (size_t)(t + 2) * kstep;
            const char* a3 = a2 + kstep; const char* b3 = b2 + kstep;
            PG8_LDB(B0, 0, 0); PG8_LDB(B1, 0, 1); PG8_SCHED; PG8_LDA(At, 0, 0); PG8_STAGE(PG8_SA(1, 1), a1 + hstepA, voffA);
            PG8_WAIT_V(8); PG8_WAIT_L(0); PG8_BAR; PG8_MMA(0, 0, At, B0); PG8_MMA(0, 1, At, B1); PG8_BAR; PG8_SCHED;
            PG8_LDA(At, 0, 1); PG8_STAGE(PG8_SB(0, 0), b2, voffB); PG8_STAGE(PG8_SB(0, 1), b2 + hstepB, voffB); PG8_STAGE(PG8_SA(0, 0), a2, voffA);
            PG8_WAIT_V(8); PG8_WAIT_L(0); PG8_BAR; PG8_MMA(1, 0, At, B0); PG8_MMA(1, 1, At, B1); PG8_BAR; PG8_SCHED;
            PG8_LDB(B0, 1, 0); PG8_LDB(B1, 1, 1); PG8_SCHED; PG8_LDA(At, 1, 0); PG8_STAGE(PG8_SA(0, 1), a2 + hstepA, voffA);
            PG8_WAIT_V(8); PG8_WAIT_L(0); PG8_BAR; PG8_MMA(0, 0, At, B0); PG8_MMA(0, 1, At, B1); PG8_BAR; PG8_SCHED;
            PG8_LDA(At, 1, 1); PG8_STAGE(PG8_SB(1, 0), b3, voffB); PG8_STAGE(PG8_SB(1, 1), b3 + hstepB, voffB); PG8_STAGE(PG8_SA(1, 0), a3, voffA);
            PG8_WAIT_V(8); PG8_WAIT_L(0); PG8_BAR; PG8_MMA(1, 0, At, B0); PG8_MMA(1, 1, At, B1); PG8_BAR; PG8_SCHED;
        }
        if (wr == 0) PG8_BAR;
        const bool keep = E(acc, cur, wr, wc, fr, fq);
        if (!has_next) break;
        if (!keep) {
#pragma unroll
            for (int a = 0; a < 2; ++a)
#pragma unroll
                for (int b = 0; b < 2; ++b)
#pragma unroll
                    for (int m = 0; m < 4; ++m)
#pragma unroll
                        for (int n = 0; n < 2; ++n) acc[a][b][m][n] = (f32x4){0.f, 0.f, 0.f, 0.f};
        }
        cur = nxt; cA = nA; cB = nB; ++ui;
        if (wr == 1) PG8_BAR;
    }
    PG8_WAIT_V(0);
    PG8_BAR;
#undef PG8_SA
#undef PG8_SB
#undef PG8_STAGE
#undef PG8_LDA
#undef PG8_LDB
#undef PG8_MMA
#undef PG8_WAIT_V
#undef PG8_WAIT_L
#undef PG8_BAR
#undef PG8_SCHED
}

struct SchedTile {
    const char* A; const char* B; size_t tstepA, tstepB; int nM, nN, nwg, G, c;
    __device__ __forceinline__ void init(const void* A_, const void* B_, int lda, int ldb, int M, int N, int G_, int c_) {
        A = (const char*)A_; B = (const char*)B_; tstepA = (size_t)BM * lda * 2; tstepB = (size_t)BM * ldb * 2; nM = M / BM; nN = N / BM; nwg = nM * nN; G = G_; c = c_; }
    __device__ __forceinline__ bool tile(int i, int& pm, int& pn) const {
        const long L = (long)i * G + c; if (L >= nwg) return false;
        int wgid = (int)L; { const int q = nwg / NXCD, r = nwg % NXCD, xcd = wgid % NXCD, off = wgid / NXCD; wgid = (xcd < r ? xcd * (q + 1) : r * (q + 1) + (xcd - r) * q) + off; }
        const int nig = WGM * nN, gid = wgid / nig, fm = gid * WGM, gsz = (nM - fm) < WGM ? (nM - fm) : WGM;
        pm = fm + ((wgid % nig) % gsz); pn = (wgid % nig) / gsz; return true; }
    __device__ __forceinline__ bool next(int i, Unit& u) const {
        int pm, pn; if (!tile(i, pm, pn)) return false;
        u.pm = pm; u.pn = pn; u.g = 0; u.half = 0; u.a = A + (size_t)pm * tstepA; u.b = B + (size_t)pn * tstepB; return true; }
};
struct SchedDual {
    SchedTile t; const char* A2; const char* B2;
    __device__ __forceinline__ bool next(int i, Unit& u) const {
        int pm, pn; if (!t.tile(i >> 1, pm, pn)) return false;
        u.pm = pm; u.pn = pn; u.g = 0; u.half = i & 1;
        u.a = ((i & 1) ? A2 : t.A) + (size_t)pm * t.tstepA; u.b = ((i & 1) ? B2 : t.B) + (size_t)pn * t.tstepB; return true; }
};
struct SchedGrp {
    const char* A; const char* B; size_t gstepA, tstepA, gstepB; int G, c, nunits;
    __device__ __forceinline__ bool next(int i, Unit& u) const {
        const int L = i * G + c; if (L >= nunits) return false;
        u.g = L >> 2; u.pm = L & 3; u.pn = 0; u.half = 0; u.a = A + (size_t)u.g * gstepA + (size_t)u.pm * tstepA; u.b = B + (size_t)u.g * gstepB; return true; }
};
struct SchedMini {
    const char* PWT; const char* WIN16; int G, c;
    __device__ __forceinline__ bool next(int i, Unit& u) const {
        const int L = i * G + c; if (L >= 16) return false;
        u.pm = L >> 2; u.pn = L & 3; u.g = 0; u.half = 0; u.a = PWT + (size_t)u.pm * 256 * 256 * 2; u.b = WIN16 + ((size_t)u.pn * 256 * 1024 + (size_t)u.pm * 256) * 2; return true; }
};

struct EpiPlain {
    bf16_t* O; int ldc;
    __device__ __forceinline__ bool operator()(Acc& acc, const Unit& u, int wr, int wc, int fr, int fq) const {
        const int row0 = u.pm * BM + wr * 64 + fr, col0 = u.pn * BM + wc * 32 + 8 * fq;
#pragma unroll
        for (int ai = 0; ai < 2; ++ai)
#pragma unroll
            for (int m = 0; m < 4; ++m) { bf16_t* rowp = O + (size_t)(row0 + ai * HALF + m * 16) * ldc + col0;
#pragma unroll
                for (int bj = 0; bj < 2; ++bj) *(u32x4*)(rowp + bj * HALF) = pack8(acc[ai][bj][m][0], acc[ai][bj][m][1]); }
        return false;
    }
};
struct EpiIn {
    unsigned char* ws; unsigned char* outb;
    __device__ __forceinline__ bool operator()(Acc& acc, const Unit& u, int wr, int wc, int fr, int fq) const {
        const int sg = u.pn >> 2, mode = (sg == 3) ? 1 : (sg >= 4 ? 2 : 0);
        const int row0 = u.pm * BM + wr * 64 + fr, col0 = (u.pn & 3) * BM + wc * 32 + 8 * fq;
        const size_t so = (sg == 0) ? ((size_t)80 << 20) : (sg == 1) ? ((size_t)112 << 20) : (sg == 2) ? ((size_t)144 << 20) : (sg == 3) ? ((size_t)192 << 20) : (sg == 4) ? ((size_t)224 << 20) : ((size_t)32 << 20);
        bf16_t* base = (bf16_t*)(((sg == 5) ? outb : ws) + so);
#pragma unroll
        for (int ai = 0; ai < 2; ++ai)
#pragma unroll
            for (int m = 0; m < 4; ++m) { const int row = row0 + ai * HALF + m * 16;
#pragma unroll
                for (int bj = 0; bj < 2; ++bj) { const int col = col0 + bj * HALF; f32x4 v0 = acc[ai][bj][m][0], v1 = acc[ai][bj][m][1];
                    if (mode != 0) {
#pragma unroll
                    for (int j = 0; j < 4; ++j) { const float s0 = sigm(v0[j]), s1 = sigm(v1[j]); v0[j] = (mode == 1 ? v0[j] * s0 : s0); v1[j] = (mode == 1 ? v1[j] * s1 : s1); } }
                    const size_t off = (sg == 2) ? ((size_t)((col >> 4) * 1024 + (row >> 4)) * 384 + (size_t)((row & 15) * 16 + (col & 15))) : ((size_t)row * 1024 + col);
                    *(u32x4*)(base + off) = pack8(v0, v1); } }
        return false;
    }
};
struct EpiS {
    float* SL;
    __device__ __forceinline__ bool operator()(Acc& acc, const Unit& u, int wr, int wc, int fr, int fq) const {
        const int row0 = u.pm * BM + wr * 64 + fr, col0 = wc * 32 + 8 * fq;
#pragma unroll
        for (int ai = 0; ai < 2; ++ai)
#pragma unroll
            for (int m = 0; m < 4; ++m) { float* p = SL + ((size_t)(row0 + ai * HALF + m * 16) * 64 + u.g) * 128 + col0;
                *(f32x4*)p = acc[ai][0][m][0]; *(f32x4*)(p + 4) = acc[ai][0][m][1]; }
        return false;
    }
};
struct EpiY {
    const bf16_t* AS; const float* D; bf16_t* YG;
    __device__ __forceinline__ bool operator()(Acc& acc, const Unit& u, int wr, int wc, int fr, int fq) const {
        const int row0 = u.pm * BM + wr * 64 + fr, col0 = wc * 32 + 8 * fq, h0 = 8 * (fq & 1);
        const f32x4 d0 = *(const f32x4*)(D + u.g * 16 + h0), d1 = *(const f32x4*)(D + u.g * 16 + h0 + 4);
#pragma unroll
        for (int ai = 0; ai < 2; ++ai)
#pragma unroll
            for (int m = 0; m < 4; ++m) { const int cr = row0 + ai * HALF + m * 16;
#pragma unroll
                for (int bj = 0; bj < 2; ++bj) { const int col = col0 + bj * HALF, t = col >> 4;
                    const u32x4 uw = *(const u32x4*)(AS + ((size_t)(u.g * 1024 + cr)) * 384 + col); f32x4 u0, u1; unpack8(uw, u0, u1);
                    f32x4 v0 = acc[ai][bj][m][0] + d0 * u0, v1 = acc[ai][bj][m][1] + d1 * u1;
#pragma unroll
                    for (int j = 0; j < 4; ++j) { const float a = v0[j], b = v1[j];
                        v0[j] = a * sigm(1.5957691216f * (a + 0.044715f * a * a * a)); v1[j] = b * sigm(1.5957691216f * (b + 0.044715f * b * b * b)); }
                    *(u32x4*)(YG + (size_t)(cr * 16 + t) * 1024 + u.g * 16 + h0) = pack8(v0, v1); } }
        return false;
    }
};
struct EpiGlu {
    const bf16_t* YG; const bf16_t* ZS; bf16_t* YS; const float* bias;
    __device__ __forceinline__ bool operator()(Acc& acc, const Unit& u, int wr, int wc, int fr, int fq) const {
        const int row0 = u.pm * BM + wr * 64 + fr, col0 = u.pn * BM + wc * 32 + 8 * fq;
        f32x4 bv[2][2];
#pragma unroll
        for (int bj = 0; bj < 2; ++bj) { bv[bj][0] = *(const f32x4*)(bias + col0 + bj * HALF); bv[bj][1] = *(const f32x4*)(bias + col0 + bj * HALF + 4); }
#pragma unroll
        for (int ai = 0; ai < 2; ++ai)
#pragma unroll
            for (int m = 0; m < 4; ++m) { const size_t ro = (size_t)(row0 + ai * HALF + m * 16) * 1024 + col0;
#pragma unroll
                for (int bj = 0; bj < 2; ++bj) { f32x4 y0, y1, z0, z1; unpack8(*(const u32x4*)(YG + ro + bj * HALF), y0, y1); unpack8(*(const u32x4*)(ZS + ro + bj * HALF), z0, z1);
                    f32x4 v0 = acc[ai][bj][m][0] + bv[bj][0], v1 = acc[ai][bj][m][1] + bv[bj][1];
#pragma unroll
                    for (int j = 0; j < 4; ++j) { v0[j] = y0[j] * sigm(v0[j]) * z0[j]; v1[j] = y1[j] * sigm(v1[j]) * z1[j]; }
                    *(u32x4*)(YS + ro + bj * HALF) = pack8(v0, v1); } }
        return false;
    }
};
struct EpiBr {
    const bf16_t* GP; const bf16_t* GS; bf16_t* MG;
    __device__ __forceinline__ bool operator()(Acc& acc, const Unit& u, int wr, int wc, int fr, int fq) const {
        const int row0 = u.pm * BM + wr * 64 + fr, col0 = u.pn * BM + wc * 32 + 8 * fq;
        const bool first = (u.half == 0);
#pragma unroll
        for (int ai = 0; ai < 2; ++ai)
#pragma unroll
            for (int m = 0; m < 4; ++m) { const size_t ro = (size_t)(row0 + ai * HALF + m * 16) * 1024 + col0;
#pragma unroll
                for (int bj = 0; bj < 2; ++bj) { f32x4 s0, s1; unpack8(*(const u32x4*)(GS + ro + bj * HALF), s0, s1);
                    if (first) { f32x4 p0, p1; unpack8(*(const u32x4*)(GP + ro + bj * HALF), p0, p1);
#pragma unroll
                        for (int j = 0; j < 4; ++j) { acc[ai][bj][m][0][j] *= p0[j] * __builtin_amdgcn_rcpf(s0[j]); acc[ai][bj][m][1][j] *= p1[j] * __builtin_amdgcn_rcpf(s1[j]); }
                    } else { *(u32x4*)(MG + ro + bj * HALF) = pack8(acc[ai][bj][m][0] * s0, acc[ai][bj][m][1] * s1); } } }
        return first;
    }
};
struct EpiOut {
    float* OUT; float* SSQ;
    __device__ __forceinline__ bool operator()(Acc& acc, const Unit& u, int wr, int wc, int fr, int fq) const {
        const int row0 = u.pm * BM + wr * 64 + fr, col0 = u.pn * BM + wc * 32 + 8 * fq;
#pragma unroll
        for (int ai = 0; ai < 2; ++ai)
#pragma unroll
            for (int m = 0; m < 4; ++m) { const int row = row0 + ai * HALF + m * 16; float* p = OUT + (size_t)row * 1024 + col0; float ss = 0.f;
#pragma unroll
                for (int bj = 0; bj < 2; ++bj) { const f32x4 a = acc[ai][bj][m][0], b = acc[ai][bj][m][1];
                    *(f32x4*)(p + bj * HALF) = a; *(f32x4*)(p + bj * HALF + 4) = b;
                    ss += (a[0] * a[0] + a[1] * a[1]) + (a[2] * a[2] + a[3] * a[3]) + (b[0] * b[0] + b[1] * b[1]) + (b[2] * b[2] + b[3] * b[3]); }
                ss += __shfl_xor(ss, 16); ss += __shfl_xor(ss, 32);
                if (fq == 0) SSQ[(size_t)row * 16 + u.pn * 4 + wc] = ss; }
        return false;
    }
};
}

constexpr int NWAVES = 8;
constexpr int BATCH = 2, T = 8192, D = 1024, M = BATCH * T, NIN = 6144;
constexpr int SG = 64, SP = 64, SH = 16, CH = 16, NCR = M / CH  , KY = 384;
constexpr float RMS_EPS = 1e-6f;
typedef unsigned short bf16;
typedef unsigned v4u __attribute__((ext_vector_type(4)));
typedef float f32x4 __attribute__((ext_vector_type(4)));
#define LAS __attribute__((address_space(3)))

constexpr size_t MiB = 1u << 20;
constexpr size_t WS_CTL = 0, CTL_ZERO_BYTES = 64 * 1024;
constexpr size_t WS_MODF = 16 * 1024;
constexpr size_t WS_A16 = 1 * MiB;
constexpr size_t WS_EB = 3 * MiB;
constexpr size_t WS_SSQ = 2 * MiB;
constexpr size_t WS_WIN = 4 * MiB;
constexpr size_t WS_GLU = 16 * MiB, WS_WBP = 18 * MiB, WS_WBS = 20 * MiB, WS_WOUT = 22 * MiB;
constexpr size_t WS_PWT = 24 * MiB;
constexpr size_t WS_WIN16 = 25 * MiB;
constexpr size_t WS_BS = 28 * MiB;
constexpr size_t WS_BY = 36 * MiB;
constexpr size_t WS_H = 48 * MiB;
constexpr size_t WS_V = 80 * MiB;
constexpr size_t WS_ZP = 112 * MiB;
constexpr size_t WS_AS = 144 * MiB;
constexpr size_t WS_ZS = 192 * MiB;
constexpr size_t WS_GP = 224 * MiB;
constexpr size_t WS_END = 256 * MiB;

constexpr int LDS_BYTES = 147456;

struct Args { const float* in[22]; float* out; unsigned char* ws; int ph_lo, ph_hi; };

__device__ __forceinline__ unsigned f2bf(float f) { unsigned u = __builtin_bit_cast(unsigned, f); return (u + 0x7fffu + ((u >> 16) & 1u)) >> 16; }
__device__ __forceinline__ unsigned pk2(float lo, float hi) { return f2bf(lo) | (f2bf(hi) << 16); }
__device__ __forceinline__ float bflo(unsigned w) { return __uint_as_float(w << 16); }
__device__ __forceinline__ float bfhi(unsigned w) { return __uint_as_float(w & 0xffff0000u); }
__device__ __forceinline__ float wave_sum(float v) {
#pragma unroll
    for (int o = 1; o < 64; o <<= 1) v += __shfl_xor(v, o);
    return v;
}


#define XB_TMO      128
#define XB_XCNT(j)  (256  + 64 * (j))
#define XB_XSUB(j)  (1280 + 64 * (j))
#define XB_XGEN(j)  (2304 + 64 * (j))
#define XB_TOP      3328
#define XB_TOPGEN   3392
#define XCD_BAR_WORDS 3456
#define XB_SPIN_CAP (1u << 18)
__device__ __forceinline__ unsigned xb_ld(unsigned* p)              { return __hip_atomic_load(p, __ATOMIC_RELAXED, __HIP_MEMORY_SCOPE_AGENT); }
__device__ __forceinline__ unsigned xb_add(unsigned* p, unsigned v) { return __hip_atomic_fetch_add(p, v, __ATOMIC_RELAXED, __HIP_MEMORY_SCOPE_AGENT); }
__device__ __forceinline__ unsigned xb_xcc_id() { return (unsigned)__builtin_amdgcn_s_getreg((3 << 11) | 20) & 0xFu; }
#define XB_SPIN(cond, bar) do { unsigned _sp = 0; while (cond) { __builtin_amdgcn_s_sleep(1); \
    if ((++_sp & 255u) == 0u) { if (xb_ld(&(bar)[XB_TMO])) break; if (_sp > XB_SPIN_CAP) { atomicAdd(&(bar)[XB_TMO], 1u); break; } } } } while (0)
struct XcdBarrier { unsigned* bar; unsigned x; volatile LAS unsigned* st; };
__device__ __forceinline__ XcdBarrier xcd_barrier_post(unsigned* bar, volatile LAS unsigned* st) {
    XcdBarrier b; b.bar = bar; b.x = xb_xcc_id(); b.st = st;
    if (threadIdx.x == 0) (void)xb_add(&bar[XB_XCNT(b.x)], 1u);
    return b;
}
__device__ __forceinline__ void xcd_barrier_complete(unsigned* bar, unsigned x, unsigned& nloc, unsigned& nx) {
    const unsigned G = gridDim.x * gridDim.y * gridDim.z;
    unsigned sum, cnt, mine, sp = 0u;
    for (;;) {
        sum = 0u; cnt = 0u; mine = 0u;
#pragma unroll
        for (unsigned j = 0; j < 16; ++j) { const unsigned c = xb_ld(&bar[XB_XCNT(j)]); sum += c; cnt += (c > 0u) ? 1u : 0u; mine = (j == x) ? c : mine; }
        if (sum == G) break;
        __builtin_amdgcn_s_sleep(1);
        if ((++sp & 255u) == 0u) { if (xb_ld(&bar[XB_TMO])) break; if (sp > XB_SPIN_CAP) { atomicAdd(&bar[XB_TMO], 1u); break; } }
    }
    nloc = mine > 0u ? mine : 1u; nx = cnt > 0u ? cnt : 1u;
}
__device__ __forceinline__ void xcd_barrier(const XcdBarrier& b) {
    asm volatile("s_waitcnt vmcnt(0)" ::: "memory");
    __syncthreads();
    if (threadIdx.x == 0) {
        unsigned* bar = b.bar;
        __builtin_amdgcn_s_waitcnt(0);
        unsigned nloc = b.st[0], nx = b.st[1];
        if (nloc == 0u) { xcd_barrier_complete(bar, b.x, nloc, nx); b.st[0] = nloc; b.st[1] = nx; }
        const unsigned old = xb_add(&bar[XB_XSUB(b.x)], 1u);
        const unsigned gen = old / nloc;
        if (old + 1u == (gen + 1u) * nloc) {
            __builtin_amdgcn_fence(__ATOMIC_RELEASE, "agent");
            asm volatile("s_waitcnt vmcnt(0)" ::: "memory");
            const unsigned og = xb_add(&bar[XB_TOP], 1u);
            const unsigned tg = og / nx;
            if (og + 1u == (tg + 1u) * nx) xb_add(&bar[XB_TOPGEN], 1u);
            else XB_SPIN(xb_ld(&bar[XB_TOPGEN]) == tg, bar);
            __builtin_amdgcn_fence(__ATOMIC_ACQUIRE, "agent");
            xb_add(&bar[XB_XGEN(b.x)], 1u);
            asm volatile("s_waitcnt vmcnt(0)" ::: "memory");
        } else {
            XB_SPIN(xb_ld(&bar[XB_XGEN(b.x)]) == gen, bar);
            __builtin_amdgcn_fence(__ATOMIC_ACQUIRE, "agent");
            asm volatile("s_waitcnt vmcnt(0)" ::: "memory");
        }
    }
    __syncthreads();
}

__device__ __forceinline__ void p0_transpose_item(const float* W, int ldw, int nblk, bf16* WT, int ldt, int row_off, LAS float* scr, int item, int lane) {
    const int kb = item / nblk, nb = item % nblk, k0 = 64 * kb, n0 = 32 * nb;
#pragma unroll
    for (int i = 0; i < 32; ++i) { const int kk = 2 * i + (lane >> 5); scr[kk * 33 + (lane & 31)] = W[(size_t)(k0 + kk) * ldw + n0 + (lane & 31)]; }
    asm volatile("s_waitcnt lgkmcnt(0)" ::: "memory");
    const int c = lane & 7;
#pragma unroll
    for (int j = 0; j < 4; ++j) { const int n = (lane >> 3) + 8 * j; const LAS float* s = scr + (8 * c) * 33 + n;
        v4u o; o.x = pk2(s[0 * 33], s[1 * 33]); o.y = pk2(s[2 * 33], s[3 * 33]); o.z = pk2(s[4 * 33], s[5 * 33]); o.w = pk2(s[6 * 33], s[7 * 33]);
        *(v4u*)(WT + (size_t)(row_off + n0 + n) * ldt + k0 + 8 * c) = o; }
    asm volatile("s_waitcnt lgkmcnt(0)" ::: "memory");
}


template <int W>
__device__ __forceinline__ void yp_task(const bf16* Vb, const bf16* ZPr, bf16* YP, const float* pscale, int m0, int ch0) {
    const int tb = m0 & (T - 1);
    unsigned vv[W + 16], zz[16];
#pragma unroll
    for (int j = 0; j < W; ++j) vv[j] = (tb - W + j >= 0) ? *(const unsigned*)(Vb + (size_t)(m0 - W + j) * D + ch0) : 0u;
#pragma unroll
    for (int i = 0; i < 16; ++i) { vv[W + i] = *(const unsigned*)(Vb + (size_t)(m0 + i) * D + ch0); zz[i] = *(const unsigned*)(ZPr + (size_t)(m0 + i) * D + ch0); }
    const float ps0 = pscale[ch0], ps1 = pscale[ch0 + 1];
#pragma unroll
    for (int i = 0; i < 16; ++i) {
        float s0 = 0.f, s1 = 0.f;
#pragma unroll
        for (int d = 0; d < W; ++d) { s0 += bflo(vv[W + i - d]); s1 += bfhi(vv[W + i - d]); }
        const int t = tb + i; const float inv = 1.f / (float)((t + 1 < W) ? (t + 1) : W);
        const float z0 = bflo(zz[i]), z1 = bfhi(zz[i]);
        const float r0 = (s0 * inv - bflo(vv[W + i])) * ps0 * (z0 * pg8::sigm(z0)), r1 = (s1 * inv - bfhi(vv[W + i])) * ps1 * (z1 * pg8::sigm(z1));
        *(unsigned*)(YP + (size_t)(m0 + i) * D + ch0) = pk2(r0, r1);
    }
}

__device__ __forceinline__ void ssm_setup(const Args& args, int g, int q, LAS float* L, int tid) {
    LAS float* pwr = L;
    LAS float* pwi = L + 17 * 64;
    LAS float* bbr = L + 34 * 64;
    LAS float* bbi = bbr + 1024;
    LAS float* cre = bbi + 1024;
    LAS float* cim = cre + 1024;
    LAS float* KT = cim + 1024;
    const float* a_re = args.in[9]; const float* a_im = args.in[10]; const float* log_dt = args.in[11];
    const float* b_re = args.in[12]; const float* b_im = args.in[13]; const float* c_re = args.in[14]; const float* c_im = args.in[15];
    unsigned char* ws = args.ws;
    {
        const float dt = expf(log_dt[g]);
        for (int idx = tid; idx < 17 * 64; idx += 512) {
            const int p = idx & 63, j = idx >> 6;
            const float lr = fminf(a_re[g * 64 + p], -1e-4f), li = a_im[g * 64 + p];
            const double tj = (double)li * (double)dt * (double)j; const double kk = rint(tj * 0.15915494309189535); const float r = (float)(tj - kk * 6.283185307179586);
            const float mg = expf(lr * dt * (float)j);
            pwr[j * 64 + p] = mg * cosf(r); pwi[j * 64 + p] = mg * sinf(r);
        }
        if (tid < 64) {
            const int p = tid;
            const float lr = fminf(a_re[g * 64 + p], -1e-4f), li = a_im[g * 64 + p];
            const float xr = lr * dt; const double thd = (double)li * (double)dt;
            const double k1 = rint(thd * 0.15915494309189535); const float r1 = (float)(thd - k1 * 6.283185307179586);
            const float c1 = cosf(r1), s1 = sinf(r1), sh = sinf(0.5f * r1), mg1 = expf(xr);
            const float num_re = expm1f(xr) * c1 - 2.f * sh * sh, num_im = mg1 * s1;
            const float den = lr * lr + li * li;
            const float f_re = (num_re * lr + num_im * li) / den, f_im = (num_im * lr - num_re * li) / den;
#pragma unroll 4
            for (int h = 0; h < 16; ++h) { const float br = b_re[(g * 64 + p) * 16 + h], bi = b_im[(g * 64 + p) * 16 + h];
                bbr[p * 16 + h] = f_re * br - f_im * bi; bbi[p * 16 + h] = f_re * bi + f_im * br; }
        }
    }
    for (int i = tid; i < 1024; i += 512) { cre[i] = c_re[g * 1024 + i]; cim[i] = c_im[g * 1024 + i]; }
    __syncthreads();
    if (q == 0 && tid < 64) { float* a16 = (float*)(ws + WS_A16); a16[(g * 64 + tid) * 2] = pwr[16 * 64 + tid]; a16[(g * 64 + tid) * 2 + 1] = pwi[16 * 64 + tid]; }
    {
        const int j = tid >> 5, h = (tid >> 1) & 15, hb = (tid & 1) * 8;
        if (j < 4 * (q + 1)) {
        float kacc[8];
#pragma unroll
        for (int i = 0; i < 8; ++i) kacc[i] = 0.f;
#pragma unroll 4
        for (int p = 0; p < 64; ++p) { const float cr = cre[h * 64 + p], ci = cim[h * 64 + p], pr = pwr[j * 64 + p], pi = pwi[j * 64 + p];
            const float ar = cr * pr - ci * pi, ai = cr * pi + ci * pr;
#pragma unroll
            for (int i = 0; i < 8; ++i) kacc[i] += ar * bbr[p * 16 + hb + i] - ai * bbi[p * 16 + hb + i]; }
#pragma unroll
        for (int i = 0; i < 8; ++i) KT[(j * 16 + h) * 16 + hb + i] = kacc[i];
        }
    }
    __syncthreads();
    bf16* BY = (bf16*)(ws + WS_BY) + (size_t)g * 256 * KY;
    for (int v = tid; v < 64 * 48; v += 512) {
        const int n = 64 * q + v / 48, k0 = (v % 48) * 8, t = n >> 4, h = n & 15; float val[8];
        if (k0 < 256) { const int tp = k0 >> 4, hh0 = k0 & 15;
#pragma unroll
            for (int i = 0; i < 8; ++i) val[i] = (tp <= t) ? KT[((t - tp) * 16 + h) * 16 + hh0 + i] : 0.f;
        } else if (k0 < 320) { const int p0 = k0 - 256;
#pragma unroll
            for (int i = 0; i < 8; ++i) val[i] = cre[h * 64 + p0 + i] * pwr[(t + 1) * 64 + p0 + i] - cim[h * 64 + p0 + i] * pwi[(t + 1) * 64 + p0 + i];
        } else { const int p0 = k0 - 320;
#pragma unroll
            for (int i = 0; i < 8; ++i) val[i] = -(cre[h * 64 + p0 + i] * pwi[(t + 1) * 64 + p0 + i] + cim[h * 64 + p0 + i] * pwr[(t + 1) * 64 + p0 + i]);
        }
        v4u o; o.x = pk2(val[0], val[1]); o.y = pk2(val[2], val[3]); o.z = pk2(val[4], val[5]); o.w = pk2(val[6], val[7]);
        *(v4u*)(BY + (size_t)n * KY + k0) = o;
    }
    bf16* BS = (bf16*)(ws + WS_BS) + (size_t)g * 256 * 256;
    for (int v = tid; v < 64 * 32; v += 512) {
        const int n = 64 * q + (v >> 5), k0 = (v & 31) * 8, t = k0 >> 4, hh0 = k0 & 15; float val[8];
        if (n < 128) { const int p = n & 63; const float pr = pwr[(15 - t) * 64 + p], pi = pwi[(15 - t) * 64 + p];
#pragma unroll
            for (int i = 0; i < 8; ++i) { const float br = bbr[p * 16 + hh0 + i], bi = bbi[p * 16 + hh0 + i]; val[i] = (n < 64) ? (pr * br - pi * bi) : (pr * bi + pi * br); }
        } else {
#pragma unroll
            for (int i = 0; i < 8; ++i) val[i] = 0.f;
        }
        v4u o; o.x = pk2(val[0], val[1]); o.y = pk2(val[2], val[3]); o.z = pk2(val[4], val[5]); o.w = pk2(val[6], val[7]);
        *(v4u*)(BS + (size_t)n * 256 + k0) = o;
    }
    __syncthreads();
}

__global__ void __launch_bounds__(NWAVES * 64, 2) fwd_megakernel(Args args) {
    extern __shared__ __attribute__((aligned(16))) unsigned char lds_raw[];
    LAS unsigned char* lds = (LAS unsigned char*)lds_raw;
    const int tid = threadIdx.x, lane = tid & 63, wave = __builtin_amdgcn_readfirstlane(tid >> 6);
    const int G = gridDim.x, bx = blockIdx.x;
    const int gw = bx * NWAVES + wave, NGW = G * NWAVES;
    unsigned char* ws = args.ws;
#if MK_SPLIT
    const int lo = args.ph_lo, hi = args.ph_hi;
#else
    constexpr int lo = 0, hi = 10;
#endif
#ifndef MK_PHASES
#define MK_PHASES 0x3ff
#endif
#define IN(k) (((MK_PHASES >> (k)) & 1) && lo <= (k) && (k) < hi)
#if MK_USE_CG
#define GRID_BAR(k) do { if (IN(k) && IN((k) + 1)) { cg::this_grid().sync(); } } while (0)
#else
#define GRID_BAR(k) do { if (IN(k) && IN((k) + 1)) { xcd_barrier(xbar); } } while (0)
    if (tid < 2) ((volatile LAS unsigned*)(lds + 131072 + 1024))[tid] = 0u;
    __syncthreads();
    const XcdBarrier xbar = xcd_barrier_post((unsigned*)(ws + WS_CTL), (volatile LAS unsigned*)(lds + 131072 + 1024));
    if (args.ph_hi == 12345) cg::this_grid().sync();
#endif

    const float* x = args.in[0];
    bf16* WIN = (bf16*)(ws + WS_WIN); bf16* GLUT = (bf16*)(ws + WS_GLU); bf16* WBP = (bf16*)(ws + WS_WBP); bf16* WBS = (bf16*)(ws + WS_WBS); bf16* WOUT = (bf16*)(ws + WS_WOUT);
    bf16* PWT = (bf16*)(ws + WS_PWT); bf16* WIN16 = (bf16*)(ws + WS_WIN16);
    bf16* Hb = (bf16*)(ws + WS_H); bf16* Vb = (bf16*)(ws + WS_V); bf16* ZP = (bf16*)(ws + WS_ZP); bf16* AS = (bf16*)(ws + WS_AS); bf16* ZS = (bf16*)(ws + WS_ZS); bf16* GP = (bf16*)(ws + WS_GP);
    bf16* GS = (bf16*)((unsigned char*)args.out + 32 * MiB); float* SL = (float*)args.out;
    bf16* YP = Hb; bf16* YG = Vb; bf16* MG = ZP; bf16* YS = (bf16*)args.out;
    float* EB = (float*)(ws + WS_EB); float* MODF = (float*)(ws + WS_MODF); float* A16 = (float*)(ws + WS_A16); float* SSQ = (float*)(ws + WS_SSQ);

    for (int rep = 0; rep <= ((MK_REPEAT >> 0) & 1); ++rep) { if (rep) xcd_barrier(xbar);
    if (IN(0)) {
        for (int it = bx; it < 4 * SG; it += G) ssm_setup(args, it >> 2, it & 3, (LAS float*)lds, tid);
        LAS float* scr = (LAS float*)(lds + wave * 16384);
        constexpr int I_IN = 16 * 160, I_SQ = 16 * 32, I_PW = 4 * 8;
        constexpr int NT = I_IN + 4 * I_SQ + 4 * I_PW, NCV = 1024, NGV = 48 * 32;
        for (int it = gw; it < NT + NCV + NGV; it += NGW) {
            int r = it;
            if (r < I_IN) { p0_transpose_item(args.in[6] + 1024, NIN, 160, WIN, 1024, 1024, scr, r, lane); continue; } r -= I_IN;
            if (r < I_SQ) { p0_transpose_item(args.in[17], 1024, 32, GLUT, 1024, 0, scr, r, lane); continue; } r -= I_SQ;
            if (r < I_SQ) { p0_transpose_item(args.in[19], 1024, 32, WBP, 1024, 0, scr, r, lane); continue; } r -= I_SQ;
            if (r < I_SQ) { p0_transpose_item(args.in[20], 1024, 32, WBS, 1024, 0, scr, r, lane); continue; } r -= I_SQ;
            if (r < I_SQ) { p0_transpose_item(args.in[21], 1024, 32, WOUT, 1024, 0, scr, r, lane); continue; } r -= I_SQ;
            if (r < 4 * I_PW) { const int pg = r / I_PW; p0_transpose_item(args.in[7] + (size_t)pg * 65536, 256, 8, PWT, 256, pg * 256, scr, r % I_PW, lane); continue; } r -= 4 * I_PW;
            if (r < NCV) {
                const float* src = args.in[6] + (size_t)r * NIN; bf16* dst = WIN16 + (size_t)r * 1024;
#pragma unroll
                for (int j = 0; j < 4; ++j) { const f32x4 v = *(const f32x4*)(src + 4 * lane + 256 * j);
                    *(unsigned long long*)(dst + 4 * lane + 256 * j) = (unsigned long long)pk2(v.x, v.y) | ((unsigned long long)pk2(v.z, v.w) << 32); }
                continue; } r -= NCV;
            {
                const int jb = r >> 5, ks = r & 31, j = jb * 64 + lane; const float* cc = args.in[1]; const float* wa = args.in[2];
                float p0 = 0.f, p1 = 0.f;
#pragma unroll
                for (int kk = 0; kk < 32; ++kk) { const int k = ks * 32 + kk; const float c0 = cc[k], c1 = cc[1024 + k]; const float a0 = c0 * pg8::sigm(c0), a1 = c1 * pg8::sigm(c1);
                    const float w = wa[(size_t)k * 3072 + j]; p0 += a0 * w; p1 += a1 * w; }
                __hip_atomic_fetch_add(MODF + j, p0, __ATOMIC_RELAXED, __HIP_MEMORY_SCOPE_AGENT); __hip_atomic_fetch_add(MODF + 3072 + j, p1, __ATOMIC_RELAXED, __HIP_MEMORY_SCOPE_AGENT);
            }
        }
    }
    }
    GRID_BAR(0);

    for (int rep = 0; rep <= ((MK_REPEAT >> 1) & 1); ++rep) { if (rep) xcd_barrier(xbar);
    if (IN(1)) {
        if (bx < 16) {
            pg8::SchedMini S{(const char*)PWT, (const char*)WIN16, G, bx}; pg8::EpiPlain E{WIN, 1024};
            pg8::gemm_phase<pg8::EpiPlain, pg8::SchedMini, 256, 1024, 256>(lds, S, E);
        }
        __syncthreads();
        LAS float* modl = (LAS float*)lds;
        for (int i = tid; i < 6144; i += 512) { const int j = i % 3072; modl[i] = args.in[3][j] + MODF[i]; }
        __syncthreads();
        const float* gain = args.in[4];
        if (bx >= 16 || G <= 16) {
            const int rw = (G > 16) ? gw - 16 * NWAVES : gw, rs = (G > 16) ? NGW - 16 * NWAVES : NGW;
            f32x4 v[4], vn[4];
            if (rw < M) {
#pragma unroll
                for (int j = 0; j < 4; ++j) v[j] = *(const f32x4*)(x + (size_t)rw * D + 4 * lane + 256 * j);
            }
            for (int m = rw; m < M; m += rs) {
                const int mn = m + rs;
                if (mn < M) {
#pragma unroll
                    for (int j = 0; j < 4; ++j) vn[j] = *(const f32x4*)(x + (size_t)mn * D + 4 * lane + 256 * j);
                }
                const int b = m >> 13; float sq = 0.f;
#pragma unroll
                for (int j = 0; j < 4; ++j) sq += (v[j].x * v[j].x + v[j].y * v[j].y) + (v[j].z * v[j].z + v[j].w * v[j].w);
                const float rstd = rsqrtf(wave_sum(sq) * (1.f / D) + RMS_EPS);
#pragma unroll
                for (int j = 0; j < 4; ++j) { const int col = 4 * lane + 256 * j; const f32x4 gn = *(const f32x4*)(gain + col);
                    const f32x4 sh = *(const LAS f32x4*)(modl + b * 3072 + col), sc = *(const LAS f32x4*)(modl + b * 3072 + 1024 + col);
                    const f32x4 h = v[j] * rstd * gn * (sc + 1.f) + sh;
                    *(unsigned long long*)(Hb + (size_t)m * D + col) = (unsigned long long)pk2(h.x, h.y) | ((unsigned long long)pk2(h.z, h.w) << 32); }
#pragma unroll
                for (int j = 0; j < 4; ++j) v[j] = vn[j];
            }
        }
        __syncthreads();
    }
    }
    GRID_BAR(1);

    for (int rep = 0; rep <= ((MK_REPEAT >> 2) & 1); ++rep) { if (rep) xcd_barrier(xbar);
    if (IN(2)) {
        pg8::SchedTile S; S.init(Hb, WIN, 1024, 1024, M, NIN, G, bx);
        pg8::EpiIn E{ws, (unsigned char*)args.out};
        static_assert(WS_V == (80u << 20) && WS_ZP == (112u << 20) && WS_AS == (144u << 20) && WS_ZS == (192u << 20) && WS_GP == (224u << 20), "EpiIn segment map");
        pg8::gemm_phase<pg8::EpiIn, pg8::SchedTile, 1024, 1024, 1024>(lds, S, E);
    }
    }
    GRID_BAR(2);

    for (int rep = 0; rep <= ((MK_REPEAT >> 3) & 1); ++rep) { if (rep) xcd_barrier(xbar);
    if (IN(3)) {
        pg8::SchedGrp S{(const char*)AS, (const char*)(ws + WS_BS), (size_t)NCR * KY * 2, (size_t)256 * KY * 2, (size_t)256 * 256 * 2, G, bx, 256};
        pg8::EpiS E{SL};
        pg8::gemm_phase<pg8::EpiS, pg8::SchedGrp, KY, 256, 256>(lds, S, E);
    }
    }
    GRID_BAR(3);

    for (int rep = 0; rep <= ((MK_REPEAT >> 4) & 1); ++rep) { if (rep) xcd_barrier(xbar);
    if (IN(4)) {
        for (int task = gw; task < 2048; task += NGW) {
            const int sgm = task & 15, g = (task >> 4) & 63, b = task >> 10, p = lane;
            const float ar = A16[(g * 64 + p) * 2], ai = A16[(g * 64 + p) * 2 + 1];
            const float* sl = SL + ((size_t)(b * 512 + sgm * 32) * 64 + g) * 128 + p;
            float er = 0.f, ei = 0.f;
#pragma unroll
            for (int c = 0; c < 32; ++c) { const float lr = sl[(size_t)c * 64 * 128], li = sl[(size_t)c * 64 * 128 + 64];
                const float nr = ar * er - ai * ei + lr, ni = ar * ei + ai * er + li; er = nr; ei = ni; }
            EB[(size_t)task * 128 + p] = er; EB[(size_t)task * 128 + 64 + p] = ei;
        }
        xcd_barrier(xbar);
        for (int task = gw; task < 2048; task += NGW) {
            const int sgm = task & 15, g = (task >> 4) & 63, b = task >> 10, p = lane;
            const float ar = A16[(g * 64 + p) * 2], ai = A16[(g * 64 + p) * 2 + 1];
            float qr = ar, qi = ai;
#pragma unroll
            for (int i = 0; i < 5; ++i) { const float nr = qr * qr - qi * qi, ni = 2.f * qr * qi; qr = nr; qi = ni; }
            float sr = 0.f, si = 0.f;
            const float* eb = EB + (size_t)(task - sgm) * 128 + p;
#pragma unroll
            for (int s2 = 0; s2 < 15; ++s2) { const bool on = s2 < sgm; const float lr = on ? eb[s2 * 128] : 0.f, li = on ? eb[s2 * 128 + 64] : 0.f;
                const float nr = qr * sr - qi * si + lr, ni = qr * si + qi * sr + li; sr = on ? nr : sr; si = on ? ni : si; }
            const float* sl = SL + ((size_t)(b * 512 + sgm * 32) * 64 + g) * 128 + p;
            bf16* as = AS + ((size_t)(g * 1024 + b * 512 + sgm * 32)) * KY + 256 + p;
#pragma unroll
            for (int c = 0; c < 32; ++c) { const float lr = sl[(size_t)c * 64 * 128], li = sl[(size_t)c * 64 * 128 + 64];
                as[(size_t)c * KY] = (bf16)f2bf(sr); as[(size_t)c * KY + 64] = (bf16)f2bf(si);
                const float nr = ar * sr - ai * si + lr, ni = ar * si + ai * sr + li; sr = nr; si = ni; }
        }
        const float* pscale = args.in[8];
        for (int task = gw; task < 8192; task += NGW) {
            const int cb = task & 7, m0 = (task >> 3) * 16, ch0 = cb * 128 + lane * 2, gi = cb >> 1;
            if (gi == 0) yp_task<2>(Vb, ZP, YP, pscale, m0, ch0); else if (gi == 1) yp_task<4>(Vb, ZP, YP, pscale, m0, ch0);
            else if (gi == 2) yp_task<8>(Vb, ZP, YP, pscale, m0, ch0); else yp_task<16>(Vb, ZP, YP, pscale, m0, ch0);
        }
    }
    }
    GRID_BAR(4);

    for (int rep = 0; rep <= ((MK_REPEAT >> 5) & 1); ++rep) { if (rep) xcd_barrier(xbar);
    if (IN(5)) {
        pg8::SchedGrp S{(const char*)AS, (const char*)(ws + WS_BY), (size_t)NCR * KY * 2, (size_t)256 * KY * 2, (size_t)256 * KY * 2, G, bx, 256};
        pg8::EpiY E{AS, args.in[16], YG};
        pg8::gemm_phase<pg8::EpiY, pg8::SchedGrp, KY, KY, KY>(lds, S, E);
    }
    }
    GRID_BAR(5);

    for (int rep = 0; rep <= ((MK_REPEAT >> 6) & 1); ++rep) { if (rep) xcd_barrier(xbar);
    if (IN(6)) {
        pg8::SchedTile S; S.init(YG, GLUT, 1024, 1024, M, D, G, bx);
        pg8::EpiGlu E{YG, ZS, YS, args.in[18]};
        pg8::gemm_phase<pg8::EpiGlu, pg8::SchedTile, 1024, 1024, 1024>(lds, S, E);
    }
    }
    GRID_BAR(6);

    for (int rep = 0; rep <= ((MK_REPEAT >> 7) & 1); ++rep) { if (rep) xcd_barrier(xbar);
    if (IN(7)) {
        pg8::SchedDual S; S.t.init(YP, WBP, 1024, 1024, M, D, G, bx); S.A2 = (const char*)YS; S.B2 = (const char*)WBS;
        pg8::EpiBr E{GP, GS, MG};
        pg8::gemm_phase<pg8::EpiBr, pg8::SchedDual, 1024, 1024, 1024>(lds, S, E);
    }
    }
    GRID_BAR(7);

    for (int rep = 0; rep <= ((MK_REPEAT >> 8) & 1); ++rep) { if (rep) xcd_barrier(xbar);
    if (IN(8)) {
        pg8::SchedTile S; S.init(MG, WOUT, 1024, 1024, M, D, G, bx);
        pg8::EpiOut E{args.out, SSQ};
        pg8::gemm_phase<pg8::EpiOut, pg8::SchedTile, 1024, 1024, 1024>(lds, S, E);
    }
    }
    GRID_BAR(8);

    for (int rep = 0; rep <= ((MK_REPEAT >> 9) & 1); ++rep) { if (rep) xcd_barrier(xbar);
    if (IN(9)) {
        const float* npost = args.in[5];
        for (int m = gw; m < M; m += NGW) {
            const int b = m >> 13;
            float ss = (lane < 16) ? SSQ[(size_t)m * 16 + lane] : 0.f;
            ss = wave_sum(ss);
            const float rstd = rsqrtf(ss * (1.f / D) + RMS_EPS);
            const float* xr = x + (size_t)m * D; float* orow = args.out + (size_t)m * D;
#pragma unroll
            for (int j = 0; j < 4; ++j) { const int col = 4 * lane + 256 * j;
                const f32x4 xv = *(const f32x4*)(xr + col), ov = *(const f32x4*)(orow + col), gn = *(const f32x4*)(npost + col), gt = *(const f32x4*)(MODF + b * 3072 + 2048 + col) + *(const f32x4*)(args.in[3] + 2048 + col);
                *(f32x4*)(orow + col) = xv + gt * (ov * rstd * gn); }
        }
    }
    }
#undef IN
#undef GRID_BAR
}

extern "C" void kernel_launch(void* const* d_in, const int* in_sizes, int n_in, void* d_out, int out_size, void* d_ws, size_t ws_size, hipStream_t stream) {
    static int grid = 0;
    if (grid == 0) {
        if (n_in != 22 || in_sizes[0] != M * D || out_size != M * D || ws_size < WS_END) { fprintf(stderr, "kernel_launch: unexpected shapes (n_in %d, in0 %d, out %d, ws %zu); nothing launched\n", n_in, n_in > 0 ? in_sizes[0] : -1, out_size, ws_size); grid = -1; return; }
        int dev = 0, cus = 0, per_cu = 0;
        if (hipGetDevice(&dev) != hipSuccess || hipDeviceGetAttribute(&cus, hipDeviceAttributeMultiprocessorCount, dev) != hipSuccess) { grid = -1; return; }
        if (hipFuncSetAttribute((const void*)fwd_megakernel, hipFuncAttributeMaxDynamicSharedMemorySize, LDS_BYTES) != hipSuccess) { fprintf(stderr, "kernel_launch: hipFuncSetAttribute failed\n"); grid = -1; return; }
        if (hipOccupancyMaxActiveBlocksPerMultiprocessor(&per_cu, (const void*)fwd_megakernel, NWAVES * 64, LDS_BYTES) != hipSuccess || per_cu < 1) { fprintf(stderr, "kernel_launch: occupancy query says %d\n", per_cu); per_cu = 1; }
        (void)hipGetLastError();
        grid = cus;
    }
    if (grid < 0) return;
#if !MK_USE_CG
    if (hipMemsetAsync((char*)d_ws + WS_CTL, 0, CTL_ZERO_BYTES, stream) != hipSuccess) { fprintf(stderr, "kernel_launch: memset of the barrier words failed\n"); return; }
#endif
    Args a{};
    for (int i = 0; i < 22; ++i) a.in[i] = (const float*)d_in[i];
    a.out = (float*)d_out; a.ws = (unsigned char*)d_ws;
#if MK_SPLIT
    for (int ph = 0; ph < 10; ++ph) {
        a.ph_lo = ph; a.ph_hi = ph + 1; void* kargs[] = {&a};
        hipError_t e = hipLaunchCooperativeKernel((const void*)fwd_megakernel, dim3(grid), dim3(NWAVES * 64), kargs, LDS_BYTES, stream);
        if (e != hipSuccess) { fprintf(stderr, "kernel_launch: cooperative launch (phase %d) failed: %s\n", ph, hipGetErrorString(e)); break; }
    }
#else
    a.ph_lo = 0; a.ph_hi = 10; void* kargs[] = {&a};
    hipError_t e = hipLaunchCooperativeKernel((const void*)fwd_megakernel, dim3(grid), dim3(NWAVES * 64), kargs, LDS_BYTES, stream);
    if (e != hipSuccess) fprintf(stderr, "kernel_launch: cooperative launch failed: %s (grid %d)\n", hipGetErrorString(e), grid);
#endif
}
```
